# Optimizing an MI355X kernel written in HIP

```python
import jax, jax.numpy as jnp
from jax import lax
import numpy as np

D_MODEL = 2048
BATCH = 1
SEQ = 16384
DEPTH = 1

ATT_HEADS = 16
ATT_KV_HEADS = 2
ATT_HEAD_DIM = 64
ATT_GROUP = ATT_HEADS // ATT_KV_HEADS
ATT_WIDTH = ATT_HEADS * ATT_HEAD_DIM
ATT_KV_WIDTH = ATT_KV_HEADS * ATT_HEAD_DIM
WINDOW = 128
BLOCK = 128
ROPE_THETA = 10000.0

GLA_HEADS = 4
GLA_WIDTH = D_MODEL // 2
GLA_KEY_WIDTH = GLA_WIDTH // 2
GLA_DK = GLA_KEY_WIDTH // GLA_HEADS
GLA_DV = GLA_WIDTH // GLA_HEADS
GLA_RANK = 16
GLA_NORMALIZER = 16.0
GLA_CHUNK = 16

MIX_WIDTH = ATT_WIDTH + GLA_WIDTH
SPLIT_SIZES = (ATT_WIDTH, ATT_KV_WIDTH, ATT_KV_WIDTH, ATT_WIDTH,
               GLA_KEY_WIDTH, GLA_KEY_WIDTH, GLA_WIDTH, GLA_WIDTH, GLA_RANK)
IN_WIDTH = sum(SPLIT_SIZES)

DN_ALPHA = (2.0 * DEPTH) ** 0.25
DN_BETA = (8.0 * DEPTH) ** -0.25
LN_EPS = 1e-5
RMS_EPS = 1e-5

kernel_name = "hymba_swa_sink_gla_deepnorm"


def _split_points():
    pts, acc = [], 0
    for s in SPLIT_SIZES[:-1]:
        acc += s
        pts.append(acc)
    return pts


def _rope_tables(seq):
    half = ATT_HEAD_DIM // 2
    inv_freq = 1.0 / (ROPE_THETA ** (jnp.arange(0, half, dtype=jnp.float32) * 2.0 / ATT_HEAD_DIM))
    ang = jnp.arange(seq, dtype=jnp.float32)[:, None] * inv_freq[None, :]
    return jnp.cos(ang)[:, None, :], jnp.sin(ang)[:, None, :]


def _rope(t, cos, sin):
    half = t.shape[-1] // 2
    t1 = t[..., :half].astype(jnp.float32)
    t2 = t[..., half:].astype(jnp.float32)
    return jnp.concatenate([t1 * cos - t2 * sin, t2 * cos + t1 * sin], axis=-1).astype(t.dtype)


def _swa_sink_attention(q, k, v, sinks):
    B, S, _, D = q.shape
    nb = S // BLOCK
    qb = q.reshape(B, nb, BLOCK, ATT_KV_HEADS, ATT_GROUP, D)
    kb = k.reshape(B, nb, BLOCK, ATT_KV_HEADS, D)
    vb = v.reshape(B, nb, BLOCK, ATT_KV_HEADS, D)

    def with_prev(t):
        prev = jnp.pad(t[:, :-1], ((0, 0), (1, 0), (0, 0), (0, 0), (0, 0)))
        return jnp.concatenate([prev, t], axis=2)

    kk, vv = with_prev(kb), with_prev(vb)
    s = jnp.einsum('bnqhgd,bnkhd->bnhgqk', qb, kk).astype(jnp.float32) * (D ** -0.5)
    qi = jnp.arange(BLOCK)[:, None]
    kj = jnp.arange(2 * BLOCK)[None, :]
    dist = qi + BLOCK - kj
    band = (dist >= 0) & (dist < WINDOW)
    mask = band[None] & ((jnp.arange(nb)[:, None, None] > 0) | (kj[None] >= BLOCK))
    s = jnp.where(mask[None, :, None, None], s, -jnp.inf)
    sink = sinks.astype(jnp.float32).reshape(ATT_KV_HEADS, ATT_GROUP)[None, None, :, :, None, None]
    m = jnp.maximum(jnp.max(s, axis=-1, keepdims=True), sink)
    p = jnp.exp(s - m)
    p = p / (jnp.sum(p, axis=-1, keepdims=True) + jnp.exp(sink - m))
    o = jnp.einsum('bnhgqk,bnkhd->bnqhgd', p.astype(v.dtype), vv)
    return o.reshape(B, S, ATT_HEADS * D)


def _gla_chunked(q, k, v, g):
    B, S, H, DK = q.shape
    DV = v.shape[-1]
    C = GLA_CHUNK
    N = S // C
    f32 = jnp.float32
    qc = (q.astype(f32) * (DK ** -0.5)).reshape(B, N, C, H, DK)
    kc = k.astype(f32).reshape(B, N, C, H, DK)
    vc = v.astype(f32).reshape(B, N, C, H, DV)
    b = jnp.cumsum(g.astype(f32).reshape(B, N, C, H, DK), axis=2)

    idx = jnp.arange(C)
    causal = (idx[:, None] >= idx[None, :])[:, :, None, None]
    diff = b[:, :, :, None] - b[:, :, None, :]
    decay = jnp.exp(jnp.where(causal, diff, -jnp.inf))
    A = jnp.einsum('bnihd,bnjhd,bnijhd->bnhij', qc, kc, decay)
    o_intra = jnp.einsum('bnhij,bnjhv->bnihv', A, vc)

    b_last = b[:, :, -1]
    q_dec = qc * jnp.exp(b)
    k_dec = kc * jnp.exp(b_last[:, :, None] - b)
    tot = jnp.exp(b_last)

    def step(state, inp):
        qd, kd, vv, tt = inp
        o = jnp.einsum('bchk,bhkv->bchv', qd, state)
        state = state * tt[..., None] + jnp.einsum('bchk,bchv->bhkv', kd, vv)
        return state, o

    sw = lambda a: jnp.moveaxis(a, 1, 0)
    state0 = jnp.zeros((B, H, DK, DV), f32)
    _, o_inter = lax.scan(step, state0, (sw(q_dec), sw(k_dec), sw(vc), sw(tot)))
    o = o_intra + jnp.moveaxis(o_inter, 0, 1)
    return o.reshape(B, S, H, DV)


def _layer_norm(z, g, b):
    zf = z.astype(jnp.float32)
    mu = jnp.mean(zf, axis=-1, keepdims=True)
    var = jnp.mean(jnp.square(zf - mu), axis=-1, keepdims=True)
    return ((zf - mu) * lax.rsqrt(var + LN_EPS) * g.astype(jnp.float32) + b.astype(jnp.float32)).astype(z.dtype)


def setup_inputs(seed: int = 0) -> dict:
    key = jax.random.key(seed)
    ks = jax.random.split(key, 9)
    x = jax.random.normal(ks[0], (BATCH, SEQ, D_MODEL), jnp.float32)
    col_scale = np.concatenate([
        np.ones(ATT_WIDTH + ATT_KV_WIDTH), np.full(ATT_KV_WIDTH, DN_BETA), np.ones(ATT_WIDTH),
        np.ones(2 * GLA_KEY_WIDTH), np.full(GLA_WIDTH, DN_BETA), np.ones(GLA_WIDTH + GLA_RANK)]).astype(np.float32)
    w_in = jax.random.normal(ks[1], (DEPTH, D_MODEL, IN_WIDTH), jnp.float32) * (D_MODEL ** -0.5) * jnp.asarray(col_scale)
    w_gk_up = jax.random.normal(ks[2], (DEPTH, GLA_RANK, GLA_KEY_WIDTH), jnp.float32) * (GLA_RANK ** -0.5)
    b_gk = 0.1 * jax.random.normal(ks[3], (DEPTH, GLA_KEY_WIDTH), jnp.float32)
    attn_sinks = jax.random.normal(ks[4], (DEPTH, ATT_HEADS), jnp.float32)
    gla_norm_w = 1.0 + 0.02 * jax.random.normal(ks[5], (DEPTH, GLA_DV), jnp.float32)
    w_out = jax.random.normal(ks[6], (DEPTH, MIX_WIDTH, D_MODEL), jnp.float32) * (MIX_WIDTH ** -0.5) * DN_BETA
    ln_g = 1.0 + 0.02 * jax.random.normal(ks[7], (DEPTH, D_MODEL), jnp.float32)
    ln_b = 0.02 * jax.random.normal(ks[8], (DEPTH, D_MODEL), jnp.float32)
    return {"x": x, "w_in": w_in, "w_gk_up": w_gk_up, "b_gk": b_gk, "attn_sinks": attn_sinks,
            "gla_norm_w": gla_norm_w, "w_out": w_out, "ln_g": ln_g, "ln_b": ln_b}


def reference(x, w_in, w_gk_up, b_gk, attn_sinks, gla_norm_w, w_out, ln_g, ln_b):
    B, S, _ = x.shape
    cos, sin = _rope_tables(S)
    pts = _split_points()
    for l in range(DEPTH):
        h = jnp.einsum('bsd,de->bse', x, w_in[l])
        q_a, k_a, v_a, z_a, q_g, k_g, v_g, z_g, gk_lr = jnp.split(h, pts, axis=-1)

        qa = _rope(q_a.reshape(B, S, ATT_HEADS, ATT_HEAD_DIM), cos, sin)
        ka = _rope(k_a.reshape(B, S, ATT_KV_HEADS, ATT_HEAD_DIM), cos, sin)
        va = v_a.reshape(B, S, ATT_KV_HEADS, ATT_HEAD_DIM)
        y_a = _swa_sink_attention(qa, ka, va, attn_sinks[l]) * jax.nn.silu(z_a)

        gk = jnp.einsum('bsr,rk->bsk', gk_lr, w_gk_up[l]) + b_gk[l]
        gk = jax.nn.log_sigmoid(gk.astype(jnp.float32)) / GLA_NORMALIZER
        o_g = _gla_chunked(q_g.reshape(B, S, GLA_HEADS, GLA_DK),
                           k_g.reshape(B, S, GLA_HEADS, GLA_DK),
                           v_g.reshape(B, S, GLA_HEADS, GLA_DV),
                           gk.reshape(B, S, GLA_HEADS, GLA_DK))
        o_g = o_g * lax.rsqrt(jnp.mean(jnp.square(o_g), axis=-1, keepdims=True) + RMS_EPS) * gla_norm_w[l].astype(jnp.float32)
        y_g = (o_g.astype(x.dtype) * jax.nn.silu(z_g.reshape(B, S, GLA_HEADS, GLA_DV))).reshape(B, S, GLA_WIDTH)

        y = jnp.einsum('bse,ed->bsd', jnp.concatenate([y_a, y_g], axis=-1), w_out[l])
        x = _layer_norm(DN_ALPHA * x + y, ln_g[l], ln_b[l])
    return x
```

```cpp
#include <hip/hip_runtime.h>
#include <hip/hip_cooperative_groups.h>
#include <cstdio>
#include <cstdint>
namespace cg = cooperative_groups;
namespace pg8 {
#define PG8_LAS __attribute__((address_space(3)))
typedef unsigned short bf16_t;
typedef short bf16x8 __attribute__((ext_vector_type(8)));
typedef float f32x4 __attribute__((ext_vector_type(4)));
typedef unsigned u32x4 __attribute__((ext_vector_type(4)));
constexpr int BM = 256, BK = 64, HALF = 128, HTB = HALF * BK * 2  , STAGE_BYTES = 8 * HTB, NXCD = 8, WGM = 8;

__host__ __device__ __forceinline__ int lds_byte(int r, int c) { const int st = (r >> 4) * 2 + (c >> 5), rr = r & 15, cc = c & 31, ob = rr * 64 + cc * 2; return st * 1024 + (ob ^ (((ob >> 9) & 1) << 5)); }
__host__ __device__ __forceinline__ void stage_rc(int b, int& R, int& C) { const int st = b / 1024, sb = b % 1024, swz = sb ^ (((sb >> 9) & 1) << 5); R = (st >> 1) * 16 + swz / 64; C = (st & 1) * 32 + (swz % 64) / 2; }
__host__ __device__ __forceinline__ int perm32(int rho) { const int n = rho >> 4, i = rho & 15; return 8 * (i >> 2) + 4 * n + (i & 3); }

struct Unit { int pm, pn; };
struct Gemm { const bf16_t* A; const bf16_t* Bt; int M, N, K; };

struct StaticOrder {
    int nM, nN, nwg, G, c;
    __host__ __device__ void init(int M, int N, int G_, int c_) { nM = M / BM; nN = N / BM; nwg = nM * nN; G = G_; c = c_; }
    __host__ __device__ bool next(int i, Unit& u) const {
        const long L = (long)i * G + c; if (L >= nwg) return false;
        int wgid = (int)L; { const int q = nwg / NXCD, r = nwg % NXCD, xcd = wgid % NXCD, off = wgid / NXCD; wgid = (xcd < r ? xcd * (q + 1) : r * (q + 1) + (xcd - r) * q) + off; }
        const int nig = WGM * nN, gid = wgid / nig, fm = gid * WGM, gsz = (nM - fm) < WGM ? (nM - fm) : WGM;
        u.pm = fm + ((wgid % nig) % gsz); u.pn = (wgid % nig) / gsz; return true;
    }
    __device__ __forceinline__ void a_ready(const Unit&) const {}
    __device__ __forceinline__ void done(const Unit&) const {}
};

__device__ __forceinline__ unsigned cvt_pk_bf16(float lo, float hi) { unsigned r; asm volatile("v_cvt_pk_bf16_f32 %0, %1, %2" : "=v"(r) : "v"(lo), "v"(hi)); return r; }
typedef float f32x2 __attribute__((ext_vector_type(2)));
typedef unsigned u32x2 __attribute__((ext_vector_type(2)));
struct EpiBf16 {
    static constexpr bool PERM = true, AFTER_DRAIN = false;
    bf16_t* O; int ldc;
    __device__ __forceinline__ void operator()(const f32x4 (&acc)[2][2][4][2], const Unit& u, int wr, int wc, int fr, int fq) const {
        const int row0 = u.pm * BM + wr * 64 + fr; const int col0 = u.pn * BM + wc * 32 + 8 * fq;
#pragma unroll
        for (int ai = 0; ai < 2; ++ai)
#pragma unroll
            for (int m = 0; m < 4; ++m) { bf16_t* rowp = O + (size_t)(row0 + ai * HALF + m * 16) * ldc + col0;
#pragma unroll
                for (int bj = 0; bj < 2; ++bj) { const f32x4 v0 = acc[ai][bj][m][0], v1 = acc[ai][bj][m][1];
                    u32x4 w; w.x = cvt_pk_bf16(v0[0], v0[1]); w.y = cvt_pk_bf16(v0[2], v0[3]); w.z = cvt_pk_bf16(v1[0], v1[1]); w.w = cvt_pk_bf16(v1[2], v1[3]);
                    *(u32x4*)(rowp + bj * HALF) = w; } }
    }
};
struct EpiResid {
    static constexpr bool PERM = false, AFTER_DRAIN = false;
    const float* x; float* out; int ldc; float alpha;
    __device__ __forceinline__ void operator()(const f32x4 (&acc)[2][2][4][2], const Unit& u, int wr, int wc, int fr, int fq) const {
        const int col0 = u.pn * BM + wc * 32 + 4 * fq;
#pragma unroll
        for (int ai = 0; ai < 2; ++ai)
#pragma unroll
            for (int m = 0; m < 4; ++m) { const int r = ai * HALF + wr * 64 + m * 16 + fr; const size_t off = (size_t)(u.pm * BM + r) * ldc + col0;
#pragma unroll
                for (int bj = 0; bj < 2; ++bj)
#pragma unroll
                    for (int n = 0; n < 2; ++n) { const f32x4 xv = *(const f32x4*)(x + off + bj * HALF + n * 16); const f32x4 o = xv * alpha + acc[ai][bj][m][n];
                        *(f32x4*)(out + off + bj * HALF + n * 16) = o; } }
    }
};
template <class Epi, class Sched, bool ALIGN_EPI = false, bool SP2 = false>
__device__ __forceinline__ void gemm_phase(PG8_LAS unsigned char* lds, const Gemm g, const Sched& S, const Epi& E) {
    int tid = threadIdx.x; asm volatile("" : "+v"(tid));
    const int wid = __builtin_amdgcn_readfirstlane(tid >> 6), lane = tid & 63, wr = wid >> 2, wc = wid & 3, fr = lane & 15, fq = lane >> 4;
    const int K = g.K, nt = K / BK;
    unsigned voffA[2], voffB[2];
#pragma unroll
    for (int i = 0; i < 2; ++i) { int R, C; stage_rc(tid * 16 + i * 8192, R, C); const int Rb = Epi::PERM ? ((R & ~31) + perm32(R & 31)) : R;
        voffA[i] = (unsigned)(R * K + C) * 2u; voffB[i] = (unsigned)(Rb * K + C) * 2u; }
    const size_t kstep = (size_t)(BK * 2);
    const size_t hstep = (size_t)HALF * K * 2;
    const size_t tstep = 2 * hstep;
    const unsigned ldsw = (unsigned)wid * 1024u;
    const int aoff = lds_byte(wr * 64 + fr, fq * 8), boff = lds_byte(wc * 32 + fr, fq * 8);
#define PG8_SA(b, h) (((b) * 2 + (h)) * HTB)
#define PG8_SB(b, h) ((4 + (b) * 2 + (h)) * HTB)
#define PG8_STAGE(bufoff, gbase, voff) do { _Pragma("unroll") for (int _i = 0; _i < 2; ++_i) \
        __builtin_amdgcn_global_load_lds((const unsigned*)((const char*)(gbase) + (voff)[_i]), (PG8_LAS unsigned*)(lds + (bufoff) + ldsw + _i * 8192), 16, 0, 0); } while (0)
#define PG8_LDA(dst, b, h) do { _Pragma("unroll") for (int m = 0; m < 4; ++m) _Pragma("unroll") for (int k = 0; k < 2; ++k) dst[m][k] = *(const PG8_LAS bf16x8*)(lds + PG8_SA(b, h) + aoff + m * 2048 + k * 1024); } while (0)
#define PG8_LDB(dst, b, h) do { _Pragma("unroll") for (int n = 0; n < 2; ++n) _Pragma("unroll") for (int k = 0; k < 2; ++k) dst[n][k] = *(const PG8_LAS bf16x8*)(lds + PG8_SB(b, h) + boff + n * 2048 + k * 1024); } while (0)
#define PG8_MMA(ai, bj, At, Bt) do { __builtin_amdgcn_s_setprio(1); _Pragma("unroll") for (int m = 0; m < 4; ++m) _Pragma("unroll") for (int n = 0; n < 2; ++n) _Pragma("unroll") for (int k = 0; k < 2; ++k) \
        acc[ai][bj][m][n] = __builtin_amdgcn_mfma_f32_16x16x32_bf16(Bt[n][k], At[m][k], acc[ai][bj][m][n], 0, 0, 0); __builtin_amdgcn_s_setprio(0); } while (0)
#define PG8_WAIT_V(n) asm volatile("s_waitcnt vmcnt(" #n ")" ::: "memory")
#define PG8_WAIT_L(n) asm volatile("s_waitcnt lgkmcnt(" #n ")" ::: "memory")
#define PG8_BAR __builtin_amdgcn_s_barrier()
#define PG8_SCHED __builtin_amdgcn_sched_barrier(0)
    Unit cur, nxt; int ui = 0;
    if (!S.next(0, cur)) return;
    f32x4 acc[2][2][4][2];
#pragma unroll
    for (int a = 0; a < 2; ++a)
#pragma unroll
        for (int b = 0; b < 2; ++b)
#pragma unroll
            for (int m = 0; m < 4; ++m)
#pragma unroll
                for (int n = 0; n < 2; ++n) acc[a][b][m][n] = (f32x4){0.f, 0.f, 0.f, 0.f};
    bf16x8 At[4][2], B0[2][2], B1[2][2];
    const char* cA = (const char*)g.A + (size_t)cur.pm * tstep; const char* cB = (const char*)g.Bt + (size_t)cur.pn * tstep;
    S.a_ready(cur);
    if constexpr (SP2) {
        PG8_STAGE(PG8_SB(0, 0), cB, voffB); PG8_STAGE(PG8_SB(0, 1), cB + hstep, voffB); PG8_STAGE(PG8_SA(0, 0), cA, voffA); PG8_STAGE(PG8_SA(0, 1), cA + hstep, voffA);
        if (wr == 1) PG8_BAR;
        PG8_WAIT_V(2); PG8_BAR;
        PG8_STAGE(PG8_SB(1, 0), cB + kstep, voffB); PG8_STAGE(PG8_SA(1, 0), cA + kstep, voffA); PG8_STAGE(PG8_SB(1, 1), cB + hstep + kstep, voffB);
        PG8_WAIT_V(6); PG8_BAR;
    } else {
        PG8_STAGE(PG8_SB(0, 0), cB, voffB); PG8_STAGE(PG8_SA(0, 0), cA, voffA); PG8_STAGE(PG8_SB(0, 1), cB + hstep, voffB); PG8_STAGE(PG8_SA(0, 1), cA + hstep, voffA);
        if (wr == 1) PG8_BAR;
        PG8_WAIT_V(4); PG8_BAR;
        PG8_STAGE(PG8_SB(1, 0), cB + kstep, voffB); PG8_STAGE(PG8_SA(1, 0), cA + kstep, voffA); PG8_STAGE(PG8_SB(1, 1), cB + hstep + kstep, voffB);
        PG8_WAIT_V(6); PG8_BAR;
    }
    for (;;) {
        const bool has_next = S.next(ui + 1, nxt);
        const char* nA = has_next ? (const char*)g.A + (size_t)nxt.pm * tstep : cA; const char* nB = has_next ? (const char*)g.Bt + (size_t)nxt.pn * tstep : cB;
        for (int t = 0; t < nt; t += 2) {
            const bool last = (t == nt - 2);
            const char* a1 = cA + (size_t)(t + 1) * kstep;
            const char* a2 = last ? nA : cA + (size_t)(t + 2) * kstep; const char* b2 = last ? nB : cB + (size_t)(t + 2) * kstep;
            const char* a3 = a2 + kstep; const char* b3 = b2 + kstep;
            if (last && has_next) S.a_ready(nxt);
            if constexpr (SP2) {
            PG8_LDB(B0, 0, 0); PG8_LDB(B1, 0, 1); PG8_SCHED; PG8_LDA(At, 0, 0); PG8_STAGE(PG8_SA(1, 1), a1 + hstep, voffA);
            PG8_WAIT_V(8); PG8_WAIT_L(0); PG8_BAR; PG8_MMA(0, 0, At, B0); PG8_MMA(0, 1, At, B1); PG8_BAR; PG8_SCHED;
            PG8_LDA(At, 0, 1); PG8_STAGE(PG8_SB(0, 0), b2, voffB); PG8_STAGE(PG8_SB(0, 1), b2 + hstep, voffB); PG8_STAGE(PG8_SA(0, 0), a2, voffA);
            PG8_WAIT_V(8); PG8_WAIT_L(0); PG8_BAR; PG8_MMA(1, 0, At, B0); PG8_MMA(1, 1, At, B1); PG8_BAR; PG8_SCHED;
            PG8_LDB(B0, 1, 0); PG8_LDB(B1, 1, 1); PG8_SCHED; PG8_LDA(At, 1, 0); PG8_STAGE(PG8_SA(0, 1), a2 + hstep, voffA);
            PG8_WAIT_V(8); PG8_WAIT_L(0); PG8_BAR; PG8_MMA(0, 0, At, B0); PG8_MMA(0, 1, At, B1); PG8_BAR; PG8_SCHED;
            PG8_LDA(At, 1, 1); PG8_STAGE(PG8_SB(1, 0), b3, voffB); PG8_STAGE(PG8_SB(1, 1), b3 + hstep, voffB); PG8_STAGE(PG8_SA(1, 0), a3, voffA);
            PG8_WAIT_V(8); PG8_WAIT_L(0); PG8_BAR; PG8_MMA(1, 0, At, B0); PG8_MMA(1, 1, At, B1); PG8_BAR; PG8_SCHED;
            } else {
            PG8_LDB(B0, 0, 0); PG8_SCHED; PG8_LDA(At, 0, 0); PG8_STAGE(PG8_SA(1, 1), a1 + hstep, voffA);
            PG8_WAIT_L(8); PG8_BAR; PG8_WAIT_L(0); PG8_MMA(0, 0, At, B0); PG8_BAR; PG8_SCHED;
            PG8_LDB(B1, 0, 1); PG8_STAGE(PG8_SB(0, 0), b2, voffB);
            PG8_BAR; PG8_WAIT_L(0); PG8_MMA(0, 1, At, B1); PG8_BAR;
            PG8_LDA(At, 0, 1); PG8_STAGE(PG8_SA(0, 0), a2, voffA);
            PG8_BAR; PG8_WAIT_L(0); PG8_MMA(1, 0, At, B0); PG8_BAR; PG8_SCHED;
            PG8_STAGE(PG8_SB(0, 1), b2 + hstep, voffB);
            PG8_WAIT_V(6); PG8_BAR; PG8_MMA(1, 1, At, B1); PG8_BAR;
            PG8_LDB(B0, 1, 0); PG8_SCHED; PG8_LDA(At, 1, 0); PG8_STAGE(PG8_SA(0, 1), a2 + hstep, voffA);
            PG8_WAIT_L(8); PG8_BAR; PG8_WAIT_L(0); PG8_MMA(0, 0, At, B0); PG8_BAR; PG8_SCHED;
            PG8_LDB(B1, 1, 1); PG8_STAGE(PG8_SB(1, 0), b3, voffB);
            PG8_BAR; PG8_WAIT_L(0); PG8_MMA(0, 1, At, B1); PG8_BAR;
            PG8_LDA(At, 1, 1); PG8_STAGE(PG8_SA(1, 0), a3, voffA);
            PG8_BAR; PG8_WAIT_L(0); PG8_MMA(1, 0, At, B0); PG8_BAR; PG8_SCHED;
            PG8_STAGE(PG8_SB(1, 1), b3 + hstep, voffB);
            PG8_WAIT_V(6); PG8_BAR; PG8_MMA(1, 1, At, B1); PG8_BAR;
            }
        }
        if constexpr (ALIGN_EPI) { if (wr == 0) PG8_BAR; }
        if constexpr (!Epi::AFTER_DRAIN) { E(acc, cur, wr, wc, fr, fq); S.done(cur); }
        if (!has_next) break;
#pragma unroll
        for (int a = 0; a < 2; ++a)
#pragma unroll
            for (int b = 0; b < 2; ++b)
#pragma unroll
                for (int m = 0; m < 4; ++m)
#pragma unroll
                    for (int n = 0; n < 2; ++n) acc[a][b][m][n] = (f32x4){0.f, 0.f, 0.f, 0.f};
        cur = nxt; cA = nA; cB = nB; ++ui;
        if constexpr (ALIGN_EPI) { if (wr == 1) PG8_BAR; }
    }
    PG8_WAIT_V(0);
    if constexpr (!ALIGN_EPI) { if (wr == 0) PG8_BAR; }
    PG8_BAR;
    if constexpr (Epi::AFTER_DRAIN) { E.fused(acc, cur, wr, wc, fr, fq, lds, wid, lane); S.done(cur); }
#undef PG8_SA
#undef PG8_SB
#undef PG8_STAGE
#undef PG8_LDA
#undef PG8_LDB
#undef PG8_MMA
#undef PG8_WAIT_V
#undef PG8_WAIT_L
#undef PG8_BAR
#undef PG8_SCHED
}
}

#define LAS __attribute__((address_space(3)))
typedef unsigned short bf16_t;
typedef short bf16x8 __attribute__((ext_vector_type(8)));
typedef float f32x4 __attribute__((ext_vector_type(4)));
typedef float f32x2 __attribute__((ext_vector_type(2)));
typedef unsigned u32x4 __attribute__((ext_vector_type(4)));
typedef unsigned u32x2 __attribute__((ext_vector_type(2)));

constexpr int SEQ = 16384, DM = 2048, INW = 5392, NH = 5632;
constexpr int CQA = 0, CKA = 1024, CVA = 1152, CZA = 1280, CQG = 2304, CKG = 2816, CVG = 3328, CZG = 4352, CLR = 5376;
constexpr int GC = 128, NCH = SEQ / GC;
constexpr int NTHREADS = 512, NWAVES = 8;
constexpr int LDS_BYTES = 147456;
constexpr float LN_EPS = 1e-5f, RMS_EPS = 1e-5f;
constexpr size_t MiB = 1u << 20;
constexpr size_t WS_XB = 0;
constexpr size_t WS_WIN = 64 * MiB;
constexpr size_t WS_WOUT = 88 * MiB;
constexpr size_t WS_ROPE = 96 * MiB;
constexpr size_t WS_TOT = 100 * MiB;
constexpr size_t WS_H = 104 * MiB;
constexpr size_t WS_Y = 280 * MiB;
constexpr size_t WS_KV = 344 * MiB;
constexpr size_t WS_SC = 408 * MiB;
constexpr size_t WS_CTL = 440 * MiB, CTL_BYTES = 16384;
constexpr size_t WS_END = 441 * MiB;
constexpr int MISC_OFF = LDS_BYTES - 64;

__constant__ float INVF[32] = {1.000000000e+00f,7.498942018e-01f,5.623413324e-01f,4.216965139e-01f,3.162277639e-01f,2.371373922e-01f,1.778279394e-01f,1.333521456e-01f,1.000000015e-01f,7.498941571e-02f,5.623412877e-02f,4.216964915e-02f,3.162277862e-02f,2.371373586e-02f,1.778279431e-02f,1.333521493e-02f,9.999999776e-03f,7.498942316e-03f,5.623413250e-03f,4.216964822e-03f,3.162277862e-03f,2.371373819e-03f,1.778279431e-03f,1.333521446e-03f,1.000000047e-03f,7.498941850e-04f,5.623413017e-04f,4.216965463e-04f,3.162277862e-04f,2.371373848e-04f,1.778279402e-04f,1.333521504e-04f};

struct Params {
    const float* x; const float* w_in; const float* w_gk_up; const float* b_gk; const float* sinks; const float* gla_norm_w; const float* w_out; const float* ln_g; const float* ln_b;
    float* out; unsigned char* ws;
};

typedef __bf16 bf16x2_t __attribute__((ext_vector_type(2)));
__device__ __forceinline__ unsigned pk_bf16(float lo, float hi) { const f32x2 v = {lo, hi}; return __builtin_bit_cast(unsigned, __builtin_convertvector(v, bf16x2_t)); }
__device__ __forceinline__ float bflo(unsigned w) { return __uint_as_float(w << 16); }
__device__ __forceinline__ float bfhi(unsigned w) { return __uint_as_float(w & 0xffff0000u); }
__device__ __forceinline__ float bf2f(bf16_t v) { return __uint_as_float((unsigned)v << 16); }
__device__ __forceinline__ float silu(float z) { return z * __builtin_amdgcn_rcpf(1.f + __builtin_amdgcn_exp2f(z * -1.4426950408889634f)); }
__device__ __forceinline__ f32x4 mfma16(bf16x8 a, bf16x8 b, f32x4 c) { return __builtin_amdgcn_mfma_f32_16x16x32_bf16(a, b, c, 0, 0, 0); }
#define LDS_WAIT() asm volatile("s_waitcnt lgkmcnt(0)" ::: "memory")


#define RLX_AGENT __ATOMIC_RELAXED, __HIP_MEMORY_SCOPE_AGENT
#define XB_TMO      128
#define XB_XCNT(j)  (256  + 64 * (j))
#define XB_XSUB(j)  (1280 + 64 * (j))
#define XB_XGEN(j)  (2304 + 64 * (j))
#define XB_TOP      3328
#define XB_TOPGEN   3392
#define XCD_BAR_WORDS 3456
#define XB_SPIN_CAP (1u << 18)

__device__ __forceinline__ unsigned xb_ld(unsigned* p)              { return __hip_atomic_load(p, __ATOMIC_RELAXED, __HIP_MEMORY_SCOPE_AGENT); }
__device__ __forceinline__ unsigned xb_add(unsigned* p, unsigned v) { return __hip_atomic_fetch_add(p, v, __ATOMIC_RELAXED, __HIP_MEMORY_SCOPE_AGENT); }
__device__ __forceinline__ unsigned xb_xcc_id() { return (unsigned)__builtin_amdgcn_s_getreg((3 << 11) | 20) & 0xFu; }
#define XB_SPIN(cond, bar) do { unsigned _sp = 0; while (cond) { __builtin_amdgcn_s_sleep(1); \
    if ((++_sp & 255u) == 0u) { if (xb_ld(&(bar)[XB_TMO])) break; if (_sp > XB_SPIN_CAP) { atomicAdd(&(bar)[XB_TMO], 1u); break; } } } } while (0)

struct XcdBarrier {
    unsigned* bar; unsigned x;
    volatile LAS unsigned* st;
};

__device__ __forceinline__ XcdBarrier xcd_barrier_post(unsigned* bar, volatile LAS unsigned* st) {
    XcdBarrier b; b.bar = bar; b.x = xb_xcc_id(); b.st = st;
    if (threadIdx.x == 0) (void)xb_add(&bar[XB_XCNT(b.x)], 1u);
    return b;
}
__device__ __forceinline__ void xcd_barrier_complete(unsigned* bar, unsigned x, unsigned& nloc, unsigned& nx) {
    const unsigned G = gridDim.x * gridDim.y * gridDim.z;
    unsigned sum, cnt, mine, sp = 0u;
    for (;;) {
        sum = 0u; cnt = 0u; mine = 0u;
#pragma unroll
        for (unsigned j = 0; j < 16; ++j) { const unsigned c = xb_ld(&bar[XB_XCNT(j)]); sum += c; cnt += (c > 0u) ? 1u : 0u; mine = (j == x) ? c : mine; }
        if (sum == G) break;
        __builtin_amdgcn_s_sleep(1);
        if ((++sp & 255u) == 0u) { if (xb_ld(&bar[XB_TMO])) break; if (sp > XB_SPIN_CAP) { atomicAdd(&bar[XB_TMO], 1u); break; } }
    }
    nloc = mine > 0u ? mine : 1u; nx = cnt > 0u ? cnt : 1u;
}

__device__ __forceinline__ void xcd_barrier(const XcdBarrier& b) {
    asm volatile("s_waitcnt vmcnt(0)" ::: "memory");
    __syncthreads();
    if (threadIdx.x == 0) {
        unsigned* bar = b.bar;
        __builtin_amdgcn_s_waitcnt(0);
        unsigned nloc = b.st[0], nx = b.st[1];
        if (nloc == 0u) { xcd_barrier_complete(bar, b.x, nloc, nx); b.st[0] = nloc; b.st[1] = nx; }
        const unsigned old = xb_add(&bar[XB_XSUB(b.x)], 1u);
        const unsigned gen = old / nloc;
        if (old + 1u == (gen + 1u) * nloc) {
            __builtin_amdgcn_fence(__ATOMIC_RELEASE, "agent");
            asm volatile("s_waitcnt vmcnt(0)" ::: "memory");
            const unsigned og = xb_add(&bar[XB_TOP], 1u);
            const unsigned tg = og / nx;
            if (og + 1u == (tg + 1u) * nx) xb_add(&bar[XB_TOPGEN], 1u);
            else XB_SPIN(xb_ld(&bar[XB_TOPGEN]) == tg, bar);
            __builtin_amdgcn_fence(__ATOMIC_ACQUIRE, "agent");
            xb_add(&bar[XB_XGEN(b.x)], 1u);
            asm volatile("s_waitcnt vmcnt(0)" ::: "memory");
        } else {
            XB_SPIN(xb_ld(&bar[XB_XGEN(b.x)]) == gen, bar);
            __builtin_amdgcn_fence(__ATOMIC_ACQUIRE, "agent");
            asm volatile("s_waitcnt vmcnt(0)" ::: "memory");
        }
    }
    __syncthreads();
}

__device__ __forceinline__ void p0_transpose_item(const float* W, int K, int N, int NP, bf16_t* WT, LAS float* scr, int item, int lane) {
    const int nblk = NP / 32, kb = item / nblk, nb = item % nblk, k0 = 64 * kb, n0 = 32 * nb;
    const int ncol = n0 + (lane & 31);
#pragma unroll
    for (int i = 0; i < 32; ++i) { const int kk = 2 * i + (lane >> 5); scr[kk * 33 + (lane & 31)] = (ncol < N) ? W[(size_t)(k0 + kk) * N + ncol] : 0.f; }
    LDS_WAIT(); asm volatile("" ::: "memory");
    const int c = lane & 7;
#pragma unroll
    for (int j = 0; j < 4; ++j) { const int n = (lane >> 3) + 8 * j; const LAS float* s = scr + (8 * c) * 33 + n;
        u32x4 o; o.x = pk_bf16(s[0 * 33], s[1 * 33]); o.y = pk_bf16(s[2 * 33], s[3 * 33]); o.z = pk_bf16(s[4 * 33], s[5 * 33]); o.w = pk_bf16(s[6 * 33], s[7 * 33]);
        *(u32x4*)(WT + (size_t)(n0 + n) * K + k0 + 8 * c) = o; }
    LDS_WAIT(); asm volatile("" ::: "memory");
}

__device__ __forceinline__ void phase_prologue(const Params& p, LAS unsigned char* lds, int tid, int wid, int lane) {
    unsigned char* ws = p.ws;
    const int G = gridDim.x;
    {
        const f32x4* x4 = (const f32x4*)p.x; u32x4* xb = (u32x4*)(ws + WS_XB);
        const size_t n8 = (size_t)SEQ * DM / 8, stride = (size_t)G * NTHREADS;
        for (size_t i = (size_t)blockIdx.x * NTHREADS + tid; i < n8; i += 4 * stride) {
            f32x4 a[4], b[4];
#pragma unroll
            for (int u = 0; u < 4; ++u) { const size_t idx = i + u * stride; if (idx < n8) { a[u] = __builtin_nontemporal_load(x4 + 2 * idx); b[u] = __builtin_nontemporal_load(x4 + 2 * idx + 1); } }
#pragma unroll
            for (int u = 0; u < 4; ++u) { const size_t idx = i + u * stride; if (idx < n8) {
                u32x4 w; w.x = pk_bf16(a[u].x, a[u].y); w.y = pk_bf16(a[u].z, a[u].w); w.z = pk_bf16(b[u].x, b[u].y); w.w = pk_bf16(b[u].z, b[u].w);
                xb[idx] = w; } }
        }
    }
    {
        LAS float* scr = (LAS float*)(lds + wid * 8448);
        const int gw = blockIdx.x * NWAVES + wid, NGW = G * NWAVES;
        constexpr int I_IN = (DM / 64) * (NH / 32), I_OUT = (DM / 64) * (DM / 32);
        for (int it = gw; it < I_IN + I_OUT; it += NGW) {
            if (it < I_IN) p0_transpose_item(p.w_in, DM, INW, NH, (bf16_t*)(ws + WS_WIN), scr, it, lane);
            else p0_transpose_item(p.w_out, DM, DM, DM, (bf16_t*)(ws + WS_WOUT), scr, it - I_IN, lane);
        }
    }
    {
        float* rope = (float*)(ws + WS_ROPE);
        const int n = SEQ * 32, stride = G * NTHREADS;
        for (int i = blockIdx.x * NTHREADS + tid; i < n; i += stride) {
            const int pos = i >> 5, j = i & 31;
            const float ang = (float)pos * INVF[j];
            const double a = (double)ang;
            const double kq = __builtin_rint(a * 0.63661977236758134308);
            const double y = a - kq * 1.57079632679489661923;
            const double y2 = y * y;
            double sp = -1.0 / 6227020800.0; sp = sp * y2 + 1.0 / 39916800.0; sp = sp * y2 - 1.0 / 362880.0; sp = sp * y2 + 1.0 / 5040.0; sp = sp * y2 - 1.0 / 120.0; sp = sp * y2 + 1.0 / 6.0;
            const double sn = y - y * y2 * sp;
            double cp = 1.0 / 87178291200.0; cp = cp * y2 - 1.0 / 479001600.0; cp = cp * y2 + 1.0 / 3628800.0; cp = cp * y2 - 1.0 / 40320.0; cp = cp * y2 + 1.0 / 720.0; cp = cp * y2 - 1.0 / 24.0; cp = cp * y2 + 0.5;
            const double cs = 1.0 - y2 * cp;
            const int q = ((int)kq) & 3;
            const double s_o = (q == 0) ? sn : (q == 1) ? cs : (q == 2) ? -sn : -cs;
            const double c_o = (q == 0) ? cs : (q == 1) ? -sn : (q == 2) ? -cs : sn;
            rope[(size_t)pos * 64 + j] = (float)c_o; rope[(size_t)pos * 64 + 32 + j] = (float)s_o;
        }
    }
}

typedef short s16x4 __attribute__((ext_vector_type(4)));
constexpr int A_KLD = 72, A_VLD = 72;
__device__ __forceinline__ void rope8v(const u32x4 a, const u32x4 b, const f32x4 c0, const f32x4 c1, const f32x4 s0, const f32x4 s1, float scale, u32x4& lo, u32x4& hi) {
    const unsigned aw[4] = {a.x, a.y, a.z, a.w}, bw[4] = {b.x, b.y, b.z, b.w};
    const float cs[8] = {c0.x, c0.y, c0.z, c0.w, c1.x, c1.y, c1.z, c1.w}, sn[8] = {s0.x, s0.y, s0.z, s0.w, s1.x, s1.y, s1.z, s1.w};
    unsigned lw[4], hw[4];
#pragma unroll
    for (int i = 0; i < 4; ++i) {
        const float x1a = bflo(aw[i]), x1b = bfhi(aw[i]), x2a = bflo(bw[i]), x2b = bfhi(bw[i]);
        const float o1a = (x1a * cs[2 * i] - x2a * sn[2 * i]) * scale, o1b = (x1b * cs[2 * i + 1] - x2b * sn[2 * i + 1]) * scale;
        const float o2a = (x2a * cs[2 * i] + x1a * sn[2 * i]) * scale, o2b = (x2b * cs[2 * i + 1] + x1b * sn[2 * i + 1]) * scale;
        lw[i] = pk_bf16(o1a, o1b); hw[i] = pk_bf16(o2a, o2b);
    }
    lo = (u32x4){lw[0], lw[1], lw[2], lw[3]}; hi = (u32x4){hw[0], hw[1], hw[2], hw[3]};
}
struct QPre { u32x4 a, b; f32x4 c0, c1, s0, s1; u32x4 z0, z1; };
__device__ __forceinline__ QPre attn_qload(const bf16_t* H, const float* ROPE, int pos, int hq, int fq) {
    QPre q;
    const bf16_t* qp = H + (size_t)pos * NH + CQA + hq * 64 + 8 * fq;
    q.a = *(const u32x4*)qp; q.b = *(const u32x4*)(qp + 32);
    const float* rp = ROPE + (size_t)pos * 64 + 8 * fq;
    q.c0 = *(const f32x4*)rp; q.c1 = *(const f32x4*)(rp + 4); q.s0 = *(const f32x4*)(rp + 32); q.s1 = *(const f32x4*)(rp + 36);
    const bf16_t* zp = H + (size_t)pos * NH + CZA + hq * 64 + 8 * fq;
    q.z0 = *(const u32x4*)zp; q.z1 = *(const u32x4*)(zp + 32);
    return q;
}

__device__ __forceinline__ void attn_unit(const Params& p, LAS unsigned char* lds, int nb, int kvh, int tid, int wid, int lane) {
    asm volatile("" : "+v"(tid), "+v"(lane));
    const bf16_t* H = (const bf16_t*)(p.ws + WS_H); const float* ROPE = (const float*)(p.ws + WS_ROPE); bf16_t* Y = (bf16_t*)(p.ws + WS_Y);
    LAS bf16_t* KL = (LAS bf16_t*)lds; LAS bf16_t* VT = KL + 256 * A_KLD;
    const int fr = lane & 15, fq = lane >> 4;
    const int hq = kvh * 8 + wid;
    u32x4 ka[2], kb[2], vv[4]; f32x4 kc0[2], kc1[2], ks0[2], ks1[2];
#pragma unroll
    for (int j = 0; j < 2; ++j) {
        const int task = tid + NTHREADS * j; const int key = task >> 2, g = task & 3; const int pos = (nb - 1) * 128 + key;
        ka[j] = (u32x4){0u, 0u, 0u, 0u}; kb[j] = ka[j]; kc0[j] = (f32x4){0.f, 0.f, 0.f, 0.f}; kc1[j] = kc0[j]; ks0[j] = kc0[j]; ks1[j] = kc0[j];
        if (pos >= 0) {
            const bf16_t* kp = H + (size_t)pos * NH + CKA + kvh * 64 + 8 * g;
            ka[j] = *(const u32x4*)kp; kb[j] = *(const u32x4*)(kp + 32);
            const float* rp = ROPE + (size_t)pos * 64 + 8 * g;
            kc0[j] = *(const f32x4*)rp; kc1[j] = *(const f32x4*)(rp + 4); ks0[j] = *(const f32x4*)(rp + 32); ks1[j] = *(const f32x4*)(rp + 36);
        }
    }
#pragma unroll
    for (int j = 0; j < 4; ++j) {
        const int task = tid + NTHREADS * j; const int key = task >> 3, dg = task & 7; const int pos = (nb - 1) * 128 + key;
        vv[j] = (u32x4){0u, 0u, 0u, 0u};
        if (pos >= 0) vv[j] = *(const u32x4*)(H + (size_t)pos * NH + CVA + kvh * 64 + 8 * dg);
    }
    const float sink = p.sinks[hq] * 1.4426950408889634f;
    QPre nxt = attn_qload(H, ROPE, nb * 128 + fr, hq, fq);
    __syncthreads();
#pragma unroll
    for (int j = 0; j < 2; ++j) {
        const int task = tid + NTHREADS * j; const int key = task >> 2, g = task & 3;
        u32x4 lo, hi; rope8v(ka[j], kb[j], kc0[j], kc1[j], ks0[j], ks1[j], 1.0f, lo, hi);
        *(LAS u32x4*)(KL + key * A_KLD + 8 * g) = lo; *(LAS u32x4*)(KL + key * A_KLD + 32 + 8 * g) = hi;
    }
#pragma unroll
    for (int j = 0; j < 4; ++j) {
        const int task = tid + NTHREADS * j; const int key = task >> 3, dg = task & 7;
        *(LAS u32x4*)(VT + key * A_VLD + 8 * dg) = vv[j];
    }
    __syncthreads();
#pragma unroll 1
    for (int it = 0; it < 8; ++it) {
        const int pos = nb * 128 + 16 * it + fr;
        const QPre cur = nxt;
        if (it < 7) nxt = attn_qload(H, ROPE, pos + 16, hq, fq);
        bf16x8 qlo, qhi;
        { u32x4 lo, hi; rope8v(cur.a, cur.b, cur.c0, cur.c1, cur.s0, cur.s1, 0.125f * 1.4426950408889634f, lo, hi); qlo = __builtin_bit_cast(bf16x8, lo); qhi = __builtin_bit_cast(bf16x8, hi); }
        f32x4 s[9];
#pragma unroll
        for (int j = 0; j < 9; ++j) {
            const LAS bf16_t* kp = KL + (16 * (it + j) + fr) * A_KLD + 8 * fq;
            const bf16x8 k0 = *(const LAS bf16x8*)kp, k1 = *(const LAS bf16x8*)(kp + 32);
            f32x4 acc = (f32x4){0.f, 0.f, 0.f, 0.f};
            acc = mfma16(k0, qlo, acc); acc = mfma16(k1, qhi, acc);
            s[j] = acc;
        }
#pragma unroll
        for (int r = 0; r < 4; ++r) { s[0][r] = (fr >= 4 * fq + r) ? -INFINITY : s[0][r]; s[8][r] = (4 * fq + r > fr) ? -INFINITY : s[8][r]; }
        if (nb == 0) {
#pragma unroll
            for (int j = 0; j < 8; ++j) if (it + j < 8) s[j] = (f32x4){-INFINITY, -INFINITY, -INFINITY, -INFINITY};
        }
        float m = sink;
#pragma unroll
        for (int j = 0; j < 9; ++j) m = fmaxf(fmaxf(m, fmaxf(s[j][0], s[j][1])), fmaxf(s[j][2], s[j][3]));
        m = fmaxf(m, __shfl_xor(m, 16)); m = fmaxf(m, __shfl_xor(m, 32));
        float l = 0.f;
#pragma unroll
        for (int j = 0; j < 9; ++j)
#pragma unroll
            for (int r = 0; r < 4; ++r) { const float e = __builtin_amdgcn_exp2f(s[j][r] - m); s[j][r] = e; l += e; }
        l += __shfl_xor(l, 16); l += __shfl_xor(l, 32);
        l += __builtin_amdgcn_exp2f(sink - m);
        const float inv = __builtin_amdgcn_rcpf(l);
        f32x4 o[4];
#pragma unroll
        for (int dt = 0; dt < 4; ++dt) o[dt] = (f32x4){0.f, 0.f, 0.f, 0.f};
#pragma unroll
        for (int pp = 0; pp < 5; ++pp) {
            const int j0 = 2 * pp, j1 = (pp < 4) ? 2 * pp + 1 : 2 * pp;
            u32x4 pw; pw.x = pk_bf16(s[j0][0], s[j0][1]); pw.y = pk_bf16(s[j0][2], s[j0][3]);
            if (pp < 4) { pw.z = pk_bf16(s[j1][0], s[j1][1]); pw.w = pk_bf16(s[j1][2], s[j1][3]); } else { pw.z = 0u; pw.w = 0u; }
            const bf16x8 pf = __builtin_bit_cast(bf16x8, pw);
#pragma unroll
            for (int dt = 0; dt < 4; ++dt) {
                const LAS bf16_t* vp = VT + (4 * fq + (fr >> 2)) * A_VLD + 32 * (dt >> 1) + 8 * (fr & 3) + 4 * (dt & 1);
                const s16x4 v0 = __builtin_amdgcn_ds_read_tr16_b64_v4i16((LAS s16x4*)(vp + 16 * (it + j0) * A_VLD)), v1 = __builtin_amdgcn_ds_read_tr16_b64_v4i16((LAS s16x4*)(vp + 16 * (it + j1) * A_VLD));
                o[dt] = mfma16((bf16x8){v0[0], v0[1], v0[2], v0[3], v1[0], v1[1], v1[2], v1[3]}, pf, o[dt]);
            }
        }
#pragma unroll
        for (int hh = 0; hh < 2; ++hh) {
            const int d0 = 32 * hh + 8 * fq; const u32x4 zw = hh ? cur.z1 : cur.z0; const f32x4 oa = o[2 * hh], ob = o[2 * hh + 1];
            u32x4 w;
            w.x = pk_bf16(oa[0] * inv * silu(bflo(zw.x)), oa[1] * inv * silu(bfhi(zw.x))); w.y = pk_bf16(oa[2] * inv * silu(bflo(zw.y)), oa[3] * inv * silu(bfhi(zw.y)));
            w.z = pk_bf16(ob[0] * inv * silu(bflo(zw.z)), ob[1] * inv * silu(bfhi(zw.z))); w.w = pk_bf16(ob[2] * inv * silu(bflo(zw.w)), ob[3] * inv * silu(bfhi(zw.w)));
            *(u32x4*)(Y + (size_t)pos * DM + hq * 64 + d0) = w;
        }
    }
}

constexpr int G_LD = 136;
constexpr int GL_Q = 0, GL_K = 34816, GL_V = 69632, GL_G = 139264, GL_P = 143360;
static_assert(GL_P + 2048 <= MISC_OFF, "GLA LDS map");
struct GlaLoads { u32x2 gkw; u32x4 kw[4]; u32x4 vw[8]; float wub[4]; float bias; };
__device__ __forceinline__ void gla_issue(const Params& p, const bf16_t* H, int t0, int h, int tid, GlaLoads& L) {
    L.gkw = *(const u32x2*)(H + (size_t)(t0 + (tid >> 2)) * NH + CLR + 4 * (tid & 3));
#pragma unroll
    for (int j = 0; j < 4; ++j) { const int idx = tid + NTHREADS * j, tok = idx >> 4, dg = idx & 15; L.kw[j] = *(const u32x4*)(H + (size_t)(t0 + tok) * NH + CKG + h * 128 + 8 * dg); }
#pragma unroll
    for (int j = 0; j < 8; ++j) { const int idx = tid + NTHREADS * j, tok = idx >> 5, dvg = idx & 31; L.vw[j] = *(const u32x4*)(H + (size_t)(t0 + tok) * NH + CVG + h * 256 + 8 * dvg); }
    const int dch = h * 128 + 16 * (tid >> 6) + (tid & 15), fqq = (tid >> 4) & 3;
#pragma unroll
    for (int s = 0; s < 4; ++s) L.wub[s] = p.w_gk_up[(4 * s + fqq) * 512 + dch];
    L.bias = p.b_gk[dch];
}
__device__ __forceinline__ void gla_store_gk(LAS bf16_t* GLb, const GlaLoads& L, int tid) {
    LAS bf16_t* g = GLb + (tid >> 2) * 16 + (tid & 3);
    g[0] = (bf16_t)(L.gkw.x & 0xffffu); g[4] = (bf16_t)(L.gkw.x >> 16); g[8] = (bf16_t)(L.gkw.y & 0xffffu); g[12] = (bf16_t)(L.gkw.y >> 16);
}
constexpr int V_LD = 272;
__device__ __forceinline__ void gla_store_vt(LAS bf16_t* VN, const GlaLoads& L, int tid) {
#pragma unroll
    for (int j = 0; j < 8; ++j) { const int idx = tid + NTHREADS * j, tok = idx >> 5, dvg = idx & 31; *(LAS u32x4*)(VN + tok * V_LD + 8 * dvg) = L.vw[j]; }
}
__device__ __forceinline__ bf16x8 v_frag_tr(const LAS bf16_t* VN, int c, int ks, int lane) {
    const int g = lane >> 4, q = (lane & 15) >> 2, pp = lane & 3;
    const LAS bf16_t* p0 = VN + (32 * ks + 8 * g + q) * V_LD + 16 * c + 4 * pp;
    const s16x4 a = __builtin_amdgcn_ds_read_tr16_b64_v4i16((LAS s16x4*)p0), b = __builtin_amdgcn_ds_read_tr16_b64_v4i16((LAS s16x4*)(p0 + 4 * V_LD));
    return (bf16x8){a[0], a[1], a[2], a[3], b[0], b[1], b[2], b[3]};
}
__device__ __forceinline__ bf16x8 v_frag_tr8(const LAS bf16_t* VN, int cb, int ks, int lane) {
    const int g = lane >> 4, q = (lane & 15) >> 2, pp = lane & 3;
    const LAS bf16_t* p0 = VN + (32 * ks + 8 * g + q) * V_LD + cb + 8 * pp;
    const s16x4 a = __builtin_amdgcn_ds_read_tr16_b64_v4i16((LAS s16x4*)p0), b = __builtin_amdgcn_ds_read_tr16_b64_v4i16((LAS s16x4*)(p0 + 4 * V_LD));
    return (bf16x8){a[0], a[1], a[2], a[3], b[0], b[1], b[2], b[3]};
}
__device__ __forceinline__ void gla_decay(const GlaLoads& L, const LAS bf16_t* GLb, int fr, int fq, float (&bc)[8][4], float& btot) {
    float carry = 0.f;
#pragma unroll
    for (int T = 0; T < 8; ++T) {
        const u32x2 gw = *(const LAS u32x2*)(GLb + (16 * T + fr) * 16 + 4 * fq);
        f32x4 acc = (f32x4){L.bias, L.bias, L.bias, L.bias};
        acc = __builtin_amdgcn_mfma_f32_16x16x4f32(bflo(gw.x), L.wub[0], acc, 0, 0, 0);
        acc = __builtin_amdgcn_mfma_f32_16x16x4f32(bfhi(gw.x), L.wub[1], acc, 0, 0, 0);
        acc = __builtin_amdgcn_mfma_f32_16x16x4f32(bflo(gw.y), L.wub[2], acc, 0, 0, 0);
        acc = __builtin_amdgcn_mfma_f32_16x16x4f32(bfhi(gw.y), L.wub[3], acc, 0, 0, 0);
        float cs[4]; float run = 0.f;
#pragma unroll
        for (int r = 0; r < 4; ++r) { const float z2 = acc[r] * 1.4426950408889634f; const float ls2 = fminf(z2, 0.f) - __builtin_amdgcn_logf(1.f + __builtin_amdgcn_exp2f(-fabsf(z2))); run += ls2 * (1.f / 16.f); cs[r] = run; }
        const float t0 = __shfl(run, fr), t1 = __shfl(run, fr + 16), t2 = __shfl(run, fr + 32), t3 = __shfl(run, fr + 48);
        const float base = carry + (fq > 0 ? t0 : 0.f) + (fq > 1 ? t1 : 0.f) + (fq > 2 ? t2 : 0.f);
#pragma unroll
        for (int r = 0; r < 4; ++r) bc[T][r] = base + cs[r];
        carry += (t0 + t1) + (t2 + t3);
    }
    btot = carry;
}

__device__ __forceinline__ void gla_kv_unit(const Params& p, LAS unsigned char* lds, int c, int h, int tid, int wid, int lane) {
    asm volatile("" : "+v"(tid), "+v"(lane));
    const bf16_t* H = (const bf16_t*)(p.ws + WS_H);
    LAS bf16_t* KN = (LAS bf16_t*)(lds + GL_Q);
    LAS bf16_t* KT = (LAS bf16_t*)(lds + GL_K);
    LAS bf16_t* VT = (LAS bf16_t*)(lds + GL_V);
    LAS bf16_t* GLb = (LAS bf16_t*)(lds + GL_G);
    const int t0 = c * GC, fr = lane & 15, fq = lane >> 4, d = 16 * wid + fr;
    GlaLoads L; gla_issue(p, H, t0, h, tid, L);
    __syncthreads();
    gla_store_gk(GLb, L, tid);
#pragma unroll
    for (int j = 0; j < 4; ++j) { const int idx = tid + NTHREADS * j, tok = idx >> 4, dg = idx & 15; *(LAS u32x4*)(KN + tok * G_LD + 8 * dg) = L.kw[j]; }
    gla_store_vt(VT, L, tid);
    __syncthreads();
    {
        float bc[8][4], btot;
        gla_decay(L, GLb, fr, fq, bc, btot);
#pragma unroll
        for (int T = 0; T < 8; ++T) {
            const s16x4 kv4 = __builtin_amdgcn_ds_read_tr16_b64_v4i16((LAS s16x4*)(KN + (16 * T + 4 * fq + (fr >> 2)) * G_LD + 16 * wid + 4 * (fr & 3)));
            float kt[4];
#pragma unroll
            for (int r = 0; r < 4; ++r) kt[r] = bf2f((bf16_t)kv4[r]) * __builtin_amdgcn_exp2f(-bc[T][r]);
            u32x2 w; w.x = pk_bf16(kt[0], kt[1]); w.y = pk_bf16(kt[2], kt[3]);
            *(LAS u32x2*)(KT + d * G_LD + 16 * T + 4 * fq) = w;
        }
        if (fq == 0) ((float*)(p.ws + WS_TOT))[(c * 4 + h) * 128 + d] = __builtin_amdgcn_exp2f(btot);
    }
    __syncthreads();
    bf16_t* KV = (bf16_t*)(p.ws + WS_KV) + (size_t)(c * 4 + h) * 32768;
#pragma unroll
    for (int jv = 0; jv < 2; ++jv) {
        const int dv0 = 32 * wid + 16 * jv;
        bf16x8 vf[4];
#pragma unroll
        for (int ks = 0; ks < 4; ++ks) vf[ks] = v_frag_tr(VT, 2 * wid + jv, ks, lane);
#pragma unroll
        for (int m = 0; m < 4; ++m) {
            f32x4 acc0 = (f32x4){0.f, 0.f, 0.f, 0.f}, acc1 = acc0;
#pragma unroll
            for (int ks = 0; ks < 4; ++ks) {
                const LAS bf16_t* kp = KT + (32 * m + 8 * (fr >> 2) + (fr & 3)) * G_LD + 32 * ks + 8 * fq;
                acc0 = mfma16(*(const LAS bf16x8*)kp, vf[ks], acc0); acc1 = mfma16(*(const LAS bf16x8*)(kp + 4 * G_LD), vf[ks], acc1);
            }
            u32x4 w; w.x = pk_bf16(acc0[0], acc0[1]); w.y = pk_bf16(acc0[2], acc0[3]); w.z = pk_bf16(acc1[0], acc1[1]); w.w = pk_bf16(acc1[2], acc1[3]);
            *(u32x4*)(KV + (size_t)(dv0 + fr) * 128 + 32 * m + 8 * fq) = w;
        }
    }
}

__device__ __forceinline__ void phase_scan(const Params& p, int tid) {
    const bf16_t* KV = (const bf16_t*)(p.ws + WS_KV); const float* TOT = (const float*)(p.ws + WS_TOT); bf16_t* SC = (bf16_t*)(p.ws + WS_SC);
    for (int e = blockIdx.x * NTHREADS + tid; e < 131072; e += gridDim.x * NTHREADS) {
        const int h = e >> 15, dk = e & 127;
        float s = 0.f;
        for (int c0 = 0; c0 < NCH; c0 += 16) {
            float kv[16], tt[16];
#pragma unroll
            for (int j = 0; j < 16; ++j) { kv[j] = bf2f(KV[(size_t)(c0 + j) * 131072 + e]); tt[j] = TOT[(c0 + j) * 512 + h * 128 + dk]; }
#pragma unroll
            for (int j = 0; j < 16; ++j) { SC[(size_t)(c0 + j) * 131072 + e] = (bf16_t)(pk_bf16(s, 0.f) & 0xffffu); s = tt[j] * (s + kv[j]); }
        }
    }
}

__device__ __forceinline__ void gla_out_unit(const Params& p, LAS unsigned char* lds, int c, int h, int tid, int wid, int lane) {
    asm volatile("" : "+v"(tid), "+v"(lane));
    const bf16_t* H = (const bf16_t*)(p.ws + WS_H); bf16_t* Y = (bf16_t*)(p.ws + WS_Y);
    LAS bf16_t* QL = (LAS bf16_t*)(lds + GL_Q);
    LAS bf16_t* KL = (LAS bf16_t*)(lds + GL_K);
    LAS bf16_t* VT = (LAS bf16_t*)(lds + GL_V);
    LAS bf16_t* GLb = (LAS bf16_t*)(lds + GL_G); LAS float* RS = (LAS float*)(lds + GL_G);
    const int t0 = c * GC, fr = lane & 15, fq = lane >> 4, d = 16 * wid + fr;
    GlaLoads L; gla_issue(p, H, t0, h, tid, L);
    u32x4 qw[4];
#pragma unroll
    for (int j = 0; j < 4; ++j) { const int idx = tid + NTHREADS * j, tok = idx >> 4, dg = idx & 15; qw[j] = *(const u32x4*)(H + (size_t)(t0 + tok) * NH + CQG + h * 128 + 8 * dg); }
    const bf16_t* SC = (const bf16_t*)(p.ws + WS_SC) + (size_t)(c * 4 + h) * 32768;
    bf16x8 sf[2][4];
#pragma unroll
    for (int jv = 0; jv < 2; ++jv)
#pragma unroll
        for (int ks = 0; ks < 4; ++ks) sf[jv][ks] = *(const bf16x8*)(SC + (size_t)(32 * wid + 8 * (fr >> 2) + 4 * jv + (fr & 3)) * 128 + 32 * ks + 8 * fq);
    __syncthreads();
    gla_store_gk(GLb, L, tid);
#pragma unroll
    for (int j = 0; j < 4; ++j) { const int idx = tid + NTHREADS * j, tok = idx >> 4, dg = idx & 15; *(LAS u32x4*)(QL + tok * G_LD + 8 * dg) = qw[j]; *(LAS u32x4*)(KL + tok * G_LD + 8 * dg) = L.kw[j]; }
    gla_store_vt(VT, L, tid);
    __syncthreads();
    {
        float bc[8][4], btot;
        gla_decay(L, GLb, fr, fq, bc, btot);
#pragma unroll
        for (int T = 0; T < 8; ++T) {
            const int ta = (16 * T + 4 * fq + (fr >> 2)) * G_LD + 16 * wid + 4 * (fr & 3);
            const s16x4 q4 = __builtin_amdgcn_ds_read_tr16_b64_v4i16((LAS s16x4*)(QL + ta)), k4 = __builtin_amdgcn_ds_read_tr16_b64_v4i16((LAS s16x4*)(KL + ta));
#pragma unroll
            for (int r = 0; r < 4; ++r) {
                const float e = __builtin_amdgcn_exp2f(bc[T][r]); const int o = (16 * T + 4 * fq + r) * G_LD + d;
                const float qv = bf2f((bf16_t)q4[r]) * 0.08838834764831845f * e;
                const float kv = bf2f((bf16_t)k4[r]) * __builtin_amdgcn_rcpf(e);
                QL[o] = (bf16_t)(pk_bf16(qv, 0.f) & 0xffffu);
                KL[o] = (bf16_t)(pk_bf16(kv, 0.f) & 0xffffu);
            }
        }
    }
    __syncthreads();
    f32x4 at[8];
    {
        bf16x8 qf[4];
#pragma unroll
        for (int ks = 0; ks < 4; ++ks) qf[ks] = *(const LAS bf16x8*)(QL + (16 * wid + fr) * G_LD + 32 * ks + 8 * fq);
#pragma unroll
        for (int jt = 0; jt < 8; ++jt) {
            f32x4 acc = (f32x4){0.f, 0.f, 0.f, 0.f};
            if (jt <= wid) {
#pragma unroll
                for (int ks = 0; ks < 4; ++ks) { const bf16x8 kf = *(const LAS bf16x8*)(KL + (16 * jt + fr) * G_LD + 32 * ks + 8 * fq); acc = mfma16(kf, qf[ks], acc); }
                if (jt == wid) {
#pragma unroll
                    for (int r = 0; r < 4; ++r) acc[r] = (4 * fq + r <= fr) ? acc[r] : 0.f;
                }
            }
            at[jt] = acc;
        }
    }
    __syncthreads();
#pragma unroll
    for (int jt = 0; jt < 8; ++jt) { u32x2 w; w.x = pk_bf16(at[jt][0], at[jt][1]); w.y = pk_bf16(at[jt][2], at[jt][3]); *(LAS u32x2*)(KL + (16 * wid + fr) * G_LD + 16 * jt + 4 * fq) = w; }
    __syncthreads();
    bf16x8 vf[2][4];
#pragma unroll
    for (int jv = 0; jv < 2; ++jv)
#pragma unroll
        for (int ks = 0; ks < 4; ++ks) vf[jv][ks] = v_frag_tr8(VT, 32 * wid + 4 * jv, ks, lane);
    f32x4 o[8][2];
#pragma unroll
    for (int i = 0; i < 8; ++i) {
        bf16x8 af[4], qf[4];
#pragma unroll
        for (int ks = 0; ks < 4; ++ks) { af[ks] = *(const LAS bf16x8*)(KL + (16 * i + fr) * G_LD + 32 * ks + 8 * fq); qf[ks] = *(const LAS bf16x8*)(QL + (16 * i + fr) * G_LD + 32 * ks + 8 * fq); }
        float ssp = 0.f;
#pragma unroll
        for (int jv = 0; jv < 2; ++jv) {
            f32x4 acc = (f32x4){0.f, 0.f, 0.f, 0.f};
#pragma unroll
            for (int ks = 0; ks < 4; ++ks) if (ks <= i / 2) acc = mfma16(vf[jv][ks], af[ks], acc);
#pragma unroll
            for (int ks = 0; ks < 4; ++ks) acc = mfma16(sf[jv][ks], qf[ks], acc);
            o[i][jv] = acc;
            ssp += (acc[0] * acc[0] + acc[1] * acc[1]) + (acc[2] * acc[2] + acc[3] * acc[3]);
        }
        ssp += __shfl_xor(ssp, 16); ssp += __shfl_xor(ssp, 32);
        if (fq == 0) RS[wid * 128 + 16 * i + fr] = ssp;
    }
    u32x4 zw[8];
#pragma unroll
    for (int i = 0; i < 8; ++i) zw[i] = *(const u32x4*)(H + (size_t)(t0 + 16 * i + fr) * NH + CZG + h * 256 + 32 * wid + 8 * fq);
    __syncthreads();
    const f32x4 nw0 = *(const f32x4*)(p.gla_norm_w + 32 * wid + 8 * fq), nw1 = *(const f32x4*)(p.gla_norm_w + 32 * wid + 8 * fq + 4);
#pragma unroll
    for (int i = 0; i < 8; ++i) {
        float tot = 0.f;
#pragma unroll
        for (int w = 0; w < 8; ++w) tot += RS[w * 128 + 16 * i + fr];
        const float rstd = __builtin_amdgcn_rsqf(tot * (1.f / 256.f) + RMS_EPS);
        const int tok = t0 + 16 * i + fr;
        const u32x4 z = zw[i]; const f32x4 a = o[i][0], b = o[i][1];
        u32x4 w;
        w.x = pk_bf16(a[0] * rstd * nw0.x * silu(bflo(z.x)), a[1] * rstd * nw0.y * silu(bfhi(z.x))); w.y = pk_bf16(a[2] * rstd * nw0.z * silu(bflo(z.y)), a[3] * rstd * nw0.w * silu(bfhi(z.y)));
        w.z = pk_bf16(b[0] * rstd * nw1.x * silu(bflo(z.z)), b[1] * rstd * nw1.y * silu(bfhi(z.z))); w.w = pk_bf16(b[2] * rstd * nw1.z * silu(bflo(z.w)), b[3] * rstd * nw1.w * silu(bfhi(z.w)));
        *(u32x4*)(Y + (size_t)tok * DM + 1024 + h * 256 + 32 * wid + 8 * fq) = w;
    }
}

__device__ __forceinline__ void phase_ln(const Params& p, int wid, int lane) {
    const int gw = blockIdx.x * NWAVES + wid, NGW = gridDim.x * NWAVES;
    f32x4 gg[8], bb[8];
#pragma unroll
    for (int j = 0; j < 8; ++j) { gg[j] = *((const f32x4*)p.ln_g + lane + 64 * j); bb[j] = *((const f32x4*)p.ln_b + lane + 64 * j); }
    for (int row = gw; row < SEQ; row += NGW) {
        f32x4* rp = (f32x4*)(p.out + (size_t)row * DM) + lane;
        const u32x2* xp = (const u32x2*)((const bf16_t*)(p.ws + WS_XB) + (size_t)row * DM) + lane;
        const u32x2* yp = (const u32x2*)((const bf16_t*)(p.ws + WS_KV) + (size_t)row * DM) + lane;
        f32x4 v[8]; u32x2 xw[8], yw[8]; float s = 0.f;
#pragma unroll
        for (int j = 0; j < 8; ++j) { xw[j] = xp[64 * j]; yw[j] = yp[64 * j]; }
#pragma unroll
        for (int j = 0; j < 8; ++j) { v[j] = (f32x4){bflo(xw[j].x), bfhi(xw[j].x), bflo(xw[j].y), bfhi(xw[j].y)} * 1.189207115002721f + (f32x4){bflo(yw[j].x), bfhi(yw[j].x), bflo(yw[j].y), bfhi(yw[j].y)}; s += (v[j].x + v[j].y) + (v[j].z + v[j].w); }
#pragma unroll
        for (int o = 1; o < 64; o <<= 1) s += __shfl_xor(s, o);
        const float mean = s * (1.f / DM); float q = 0.f;
#pragma unroll
        for (int j = 0; j < 8; ++j) { v[j] = v[j] - mean; q += (v[j].x * v[j].x + v[j].y * v[j].y) + (v[j].z * v[j].z + v[j].w * v[j].w); }
#pragma unroll
        for (int o = 1; o < 64; o <<= 1) q += __shfl_xor(q, o);
        const float rstd = 1.0f / sqrtf(q * (1.f / DM) + LN_EPS);
#pragma unroll
        for (int j = 0; j < 8; ++j) rp[64 * j] = v[j] * rstd * gg[j] + bb[j];
    }
}

struct OrderG1 {
    pg8::StaticOrder S; int deferred, c, Gg;
    __device__ void init(int G, int c_, int deferred_) { deferred = deferred_; c = c_; Gg = G / 2; S.init(SEQ, 20 * 256, G, c_); }
    __device__ bool next(int i, pg8::Unit& u) const {
        if (deferred) { if (c >= Gg) return false; const int L = c + i * Gg; if (L >= 128) return false; u.pm = L >> 1; u.pn = 19 + (L & 1); return true; }
        if (!S.next(i, u)) return false; if (u.pn == 19) u.pn = 21; return true;
    }
    __device__ __forceinline__ void a_ready(const pg8::Unit&) const {}
    __device__ __forceinline__ void done(const pg8::Unit&) const {}
};

__global__ void __launch_bounds__(NTHREADS, 2) hymba_mega(Params p) {
    extern __shared__ __attribute__((aligned(16))) unsigned char lds_raw[];
    LAS unsigned char* lds = (LAS unsigned char*)lds_raw;
    cg::grid_group grid = cg::this_grid();
    const int tid = threadIdx.x, lane = tid & 63, wid = __builtin_amdgcn_readfirstlane(tid >> 6);
    const int G = gridDim.x;
    volatile LAS unsigned* MISC = (volatile LAS unsigned*)(lds + MISC_OFF);
    if (tid < 16) MISC[tid] = 0u;
    __syncthreads();
    const XcdBarrier bar = xcd_barrier_post((unsigned*)(p.ws + WS_CTL), MISC);
    if (p.ws == nullptr) grid.sync();

    phase_prologue(p, lds, tid, wid, lane);
    xcd_barrier(bar);
    {
        pg8::Gemm g{(const bf16_t*)(p.ws + WS_XB), (const bf16_t*)(p.ws + WS_WIN), SEQ, NH, DM}; OrderG1 S; S.init(G, (int)blockIdx.x, 0);
        pg8::EpiBf16 E{(bf16_t*)(p.ws + WS_H), NH};
        pg8::gemm_phase<pg8::EpiBf16, OrderG1, true, true>(lds, g, S, E);
    }
    xcd_barrier(bar);
    {
        const int Gg = G / 2;
        if ((int)blockIdx.x < Gg) {
            pg8::Gemm g{(const bf16_t*)(p.ws + WS_XB), (const bf16_t*)(p.ws + WS_WIN), SEQ, NH, DM}; OrderG1 S; S.init(G, (int)blockIdx.x, 1);
            pg8::EpiBf16 E{(bf16_t*)(p.ws + WS_H), NH};
            pg8::gemm_phase<pg8::EpiBf16, OrderG1, true, true>(lds, g, S, E);
        } else {
            for (int u = (int)blockIdx.x - Gg; u < NCH * 4; u += G - Gg) gla_kv_unit(p, lds, u >> 2, u & 3, tid, wid, lane);
        }
    }
    xcd_barrier(bar);
    phase_scan(p, tid);
    xcd_barrier(bar);
    const bool attn_first = ((blockIdx.x >> 3) & 1) != 0;
    for (int u = attn_first ? (int)blockIdx.x : 256; u < 256; u += G) attn_unit(p, lds, u >> 1, u & 1, tid, wid, lane);
    for (int u = blockIdx.x; u < NCH * 4; u += G) gla_out_unit(p, lds, u >> 2, u & 3, tid, wid, lane);
    for (int u = attn_first ? 256 : (int)blockIdx.x; u < 256; u += G) attn_unit(p, lds, u >> 1, u & 1, tid, wid, lane);
    xcd_barrier(bar);
    {
        pg8::Gemm g{(const bf16_t*)(p.ws + WS_Y), (const bf16_t*)(p.ws + WS_WOUT), SEQ, DM, DM}; pg8::StaticOrder S; S.init(SEQ, DM, G, (int)blockIdx.x);
        pg8::EpiBf16 E{(bf16_t*)(p.ws + WS_KV), DM};
        pg8::gemm_phase<pg8::EpiBf16, pg8::StaticOrder, true, true>(lds, g, S, E);
    }
    xcd_barrier(bar);
    phase_ln(p, wid, lane);
}

extern "C" void kernel_launch(void* const* d_in, const int* in_sizes, int n_in, void* d_out, int out_size, void* d_ws, size_t ws_size, hipStream_t stream) {
    static int grid = 0;
    if (grid == 0) {
        if (n_in != 9 || out_size != SEQ * DM || ws_size < WS_END) { fprintf(stderr, "kernel_launch: unexpected shapes (n_in %d out %d ws %zu)\n", n_in, out_size, ws_size); grid = -1; return; }
        int dev = 0, cus = 0, per_cu = 0;
        hipGetDevice(&dev); hipDeviceGetAttribute(&cus, hipDeviceAttributeMultiprocessorCount, dev);
        if (hipFuncSetAttribute((const void*)hymba_mega, hipFuncAttributeMaxDynamicSharedMemorySize, LDS_BYTES) != hipSuccess) { fprintf(stderr, "kernel_launch: hipFuncSetAttribute failed\n"); grid = -1; return; }
        if (hipOccupancyMaxActiveBlocksPerMultiprocessor(&per_cu, (const void*)hymba_mega, NTHREADS, LDS_BYTES) != hipSuccess || per_cu < 1) { fprintf(stderr, "kernel_launch: occupancy query failed (%d)\n", per_cu); per_cu = 1; }
        (void)hipGetLastError();
        grid = cus * per_cu;
    }
    if (grid < 0) return;
    Params p{};
    p.x = (const float*)d_in[0]; p.w_in = (const float*)d_in[1]; p.w_gk_up = (const float*)d_in[2]; p.b_gk = (const float*)d_in[3]; p.sinks = (const float*)d_in[4];
    p.gla_norm_w = (const float*)d_in[5]; p.w_out = (const float*)d_in[6]; p.ln_g = (const float*)d_in[7]; p.ln_b = (const float*)d_in[8];
    p.out = (float*)d_out; p.ws = (unsigned char*)d_ws;
    if (hipMemsetAsync((char*)d_ws + WS_CTL, 0, CTL_BYTES, stream) != hipSuccess) { fprintf(stderr, "kernel_launch: memset failed\n"); return; }
    void* args[] = {&p};
    hipError_t e = hipLaunchCooperativeKernel((void*)hymba_mega, dim3(grid), dim3(NTHREADS), args, LDS_BYTES, stream);
    if (e != hipSuccess) fprintf(stderr, "cooperative launch failed: %s (grid %d)\n", hipGetErrorString(e), grid);
}
```

```cpp
#include <hip/hip_runtime.h>
#include <hip/hip_cooperative_groups.h>
#include <cstdio>
#include <cstdint>
namespace cg = cooperative_groups;
namespace pg8 {
#define PG8_LAS __attribute__((address_space(3)))
typedef unsigned short bf16_t;
typedef short bf16x8 __attribute__((ext_vector_type(8)));
typedef float f32x4 __attribute__((ext_vector_type(4)));
typedef unsigned u32x4 __attribute__((ext_vector_type(4)));
constexpr int BM = 256, BK = 64, HALF = 128, HTB = HALF * BK * 2  , STAGE_BYTES = 8 * HTB, NXCD = 8, WGM = 8;

__host__ __device__ __forceinline__ int lds_byte(int r, int c) { const int st = (r >> 4) * 2 + (c >> 5), rr = r & 15, cc = c & 31, ob = rr * 64 + cc * 2; return st * 1024 + (ob ^ (((ob >> 9) & 1) << 5)); }
__host__ __device__ __forceinline__ void stage_rc(int b, int& R, int& C) { const int st = b / 1024, sb = b % 1024, swz = sb ^ (((sb >> 9) & 1) << 5); R = (st >> 1) * 16 + swz / 64; C = (st & 1) * 32 + (swz % 64) / 2; }
__host__ __device__ __forceinline__ int perm32(int rho) { const int n = rho >> 4, i = rho & 15; return 8 * (i >> 2) + 4 * n + (i & 3); }

struct Unit { int pm, pn; };
struct Gemm { const bf16_t* A; const bf16_t* Bt; int M, N, K; };

struct StaticOrder {
    int nM, nN, nwg, G, c;
    __host__ __device__ void init(int M, int N, int G_, int c_) { nM = M / BM; nN = N / BM; nwg = nM * nN; G = G_; c = c_; }
    __host__ __device__ bool next(int i, Unit& u) const {
        const long L = (long)i * G + c; if (L >= nwg) return false;
        int wgid = (int)L; { const int q = nwg / NXCD, r = nwg % NXCD, xcd = wgid % NXCD, off = wgid / NXCD; wgid = (xcd < r ? xcd * (q + 1) : r * (q + 1) + (xcd - r) * q) + off; }
        const int nig = WGM * nN, gid = wgid / nig, fm = gid * WGM, gsz = (nM - fm) < WGM ? (nM - fm) : WGM;
        u.pm = fm + ((wgid % nig) % gsz); u.pn = (wgid % nig) / gsz; return true;
    }
    __device__ __forceinline__ void a_ready(const Unit&) const {}
    __device__ __forceinline__ void done(const Unit&) const {}
};

__device__ __forceinline__ unsigned cvt_pk_bf16(float lo, float hi) { unsigned r; asm volatile("v_cvt_pk_bf16_f32 %0, %1, %2" : "=v"(r) : "v"(lo), "v"(hi)); return r; }
typedef float f32x2 __attribute__((ext_vector_type(2)));
typedef unsigned u32x2 __attribute__((ext_vector_type(2)));
struct EpiBf16 {
    static constexpr bool PERM = true, AFTER_DRAIN = false;
    bf16_t* O; int ldc;
    __device__ __forceinline__ void operator()(const f32x4 (&acc)[2][2][4][2], const Unit& u, int wr, int wc, int fr, int fq) const {
        const int row0 = u.pm * BM + wr * 64 + fr; const int col0 = u.pn * BM + wc * 32 + 8 * fq;
#pragma unroll
        for (int ai = 0; ai < 2; ++ai)
#pragma unroll
            for (int m = 0; m < 4; ++m) { bf16_t* rowp = O + (size_t)(row0 + ai * HALF + m * 16) * ldc + col0;
#pragma unroll
                for (int bj = 0; bj < 2; ++bj) { const f32x4 v0 = acc[ai][bj][m][0], v1 = acc[ai][bj][m][1];
                    u32x4 w; w.x = cvt_pk_bf16(v0[0], v0[1]); w.y = cvt_pk_bf16(v0[2], v0[3]); w.z = cvt_pk_bf16(v1[0], v1[1]); w.w = cvt_pk_bf16(v1[2], v1[3]);
                    *(u32x4*)(rowp + bj * HALF) = w; } }
    }
};
struct EpiResid {
    static constexpr bool PERM = false, AFTER_DRAIN = false;
    const float* x; float* out; int ldc; float alpha;
    __device__ __forceinline__ void operator()(const f32x4 (&acc)[2][2][4][2], const Unit& u, int wr, int wc, int fr, int fq) const {
        const int col0 = u.pn * BM + wc * 32 + 4 * fq;
#pragma unroll
        for (int ai = 0; ai < 2; ++ai)
#pragma unroll
            for (int m = 0; m < 4; ++m) { const int r = ai * HALF + wr * 64 + m * 16 + fr; const size_t off = (size_t)(u.pm * BM + r) * ldc + col0;
#pragma unroll
                for (int bj = 0; bj < 2; ++bj)
#pragma unroll
                    for (int n = 0; n < 2; ++n) { const f32x4 xv = *(const f32x4*)(x + off + bj * HALF + n * 16); const f32x4 o = xv * alpha + acc[ai][bj][m][n];
                        *(f32x4*)(out + off + bj * HALF + n * 16) = o; } }
    }
};
template <class Epi, class Sched, bool ALIGN_EPI = false, bool SP2 = false>
__device__ __forceinline__ void gemm_phase(PG8_LAS unsigned char* lds, const Gemm g, const Sched& S, const Epi& E) {
    int tid = threadIdx.x; asm volatile("" : "+v"(tid));
    const int wid = __builtin_amdgcn_readfirstlane(tid >> 6), lane = tid & 63, wr = wid >> 2, wc = wid & 3, fr = lane & 15, fq = lane >> 4;
    const int K = g.K, nt = K / BK;
    unsigned voffA[2], voffB[2];
#pragma unroll
    for (int i = 0; i < 2; ++i) { int R, C; stage_rc(tid * 16 + i * 8192, R, C); const int Rb = Epi::PERM ? ((R & ~31) + perm32(R & 31)) : R;
        voffA[i] = (unsigned)(R * K + C) * 2u; voffB[i] = (unsigned)(Rb * K + C) * 2u; }
    const size_t kstep = (size_t)(BK * 2);
    const size_t hstep = (size_t)HALF * K * 2;
    const size_t tstep = 2 * hstep;
    const unsigned ldsw = (unsigned)wid * 1024u;
    const int aoff = lds_byte(wr * 64 + fr, fq * 8), boff = lds_byte(wc * 32 + fr, fq * 8);
#define PG8_SA(b, h) (((b) * 2 + (h)) * HTB)
#define PG8_SB(b, h) ((4 + (b) * 2 + (h)) * HTB)
#define PG8_STAGE(bufoff, gbase, voff) do { _Pragma("unroll") for (int _i = 0; _i < 2; ++_i) \
        __builtin_amdgcn_global_load_lds((const unsigned*)((const char*)(gbase) + (voff)[_i]), (PG8_LAS unsigned*)(lds + (bufoff) + ldsw + _i * 8192), 16, 0, 0); } while (0)
#define PG8_LDA(dst, b, h) do { _Pragma("unroll") for (int m = 0; m < 4; ++m) _Pragma("unroll") for (int k = 0; k < 2; ++k) dst[m][k] = *(const PG8_LAS bf16x8*)(lds + PG8_SA(b, h) + aoff + m * 2048 + k * 1024); } while (0)
#define PG8_LDB(dst, b, h) do { _Pragma("unroll") for (int n = 0; n < 2; ++n) _Pragma("unroll") for (int k = 0; k < 2; ++k) dst[n][k] = *(const PG8_LAS bf16x8*)(lds + PG8_SB(b, h) + boff + n * 2048 + k * 1024); } while (0)
#define PG8_MMA(ai, bj, At, Bt) do { __builtin_amdgcn_s_setprio(1); _Pragma("unroll") for (int m = 0; m < 4; ++m) _Pragma("unroll") for (int n = 0; n < 2; ++n) _Pragma("unroll") for (int k = 0; k < 2; ++k) \
        acc[ai][bj][m][n] = __builtin_amdgcn_mfma_f32_16x16x32_bf16(Bt[n][k], At[m][k], acc[ai][bj][m][n], 0, 0, 0); __builtin_amdgcn_s_setprio(0); } while (0)
#define PG8_WAIT_V(n) asm volatile("s_waitcnt vmcnt(" #n ")" ::: "memory")
#define PG8_WAIT_L(n) asm volatile("s_waitcnt lgkmcnt(" #n ")" ::: "memory")
#define PG8_BAR __builtin_amdgcn_s_barrier()
#define PG8_SCHED __builtin_amdgcn_sched_barrier(0)
    Unit cur, nxt; int ui = 0;
    if (!S.next(0, cur)) return;
    f32x4 acc[2][2][4][2];
#pragma unroll
    for (int a = 0; a < 2; ++a)
#pragma unroll
        for (int b = 0; b < 2; ++b)
#pragma unroll
            for (int m = 0; m < 4; ++m)
#pragma unroll
                for (int n = 0; n < 2; ++n) acc[a][b][m][n] = (f32x4){0.f, 0.f, 0.f, 0.f};
    bf16x8 At[4][2], B0[2][2], B1[2][2];
    const char* cA = (const char*)g.A + (size_t)cur.pm * tstep; const char* cB = (const char*)g.Bt + (size_t)cur.pn * tstep;
    S.a_ready(cur);
    if constexpr (SP2) {
        PG8_STAGE(PG8_SB(0, 0), cB, voffB); PG8_STAGE(PG8_SB(0, 1), cB + hstep, voffB); PG8_STAGE(PG8_SA(0, 0), cA, voffA); PG8_STAGE(PG8_SA(0, 1), cA + hstep, voffA);
        if (wr == 1) PG8_BAR;
        PG8_WAIT_V(2); PG8_BAR;
        PG8_STAGE(PG8_SB(1, 0), cB + kstep, voffB); PG8_STAGE(PG8_SA(1, 0), cA + kstep, voffA); PG8_STAGE(PG8_SB(1, 1), cB + hstep + kstep, voffB);
        PG8_WAIT_V(6); PG8_BAR;
    } else {
        PG8_STAGE(PG8_SB(0, 0), cB, voffB); PG8_STAGE(PG8_SA(0, 0), cA, voffA); PG8_STAGE(PG8_SB(0, 1), cB + hstep, voffB); PG8_STAGE(PG8_SA(0, 1), cA + hstep, voffA);
        if (wr == 1) PG8_BAR;
        PG8_WAIT_V(4); PG8_BAR;
        PG8_STAGE(PG8_SB(1, 0), cB + kstep, voffB); PG8_STAGE(PG8_SA(1, 0), cA + kstep, voffA); PG8_STAGE(PG8_SB(1, 1), cB + hstep + kstep, voffB);
        PG8_WAIT_V(6); PG8_BAR;
    }
    for (;;) {
        const bool has_next = S.next(ui + 1, nxt);
        const char* nA = has_next ? (const char*)g.A + (size_t)nxt.pm * tstep : cA; const char* nB = has_next ? (const char*)g.Bt + (size_t)nxt.pn * tstep : cB;
        for (int t = 0; t < nt; t += 2) {
            const bool last = (t == nt - 2);
            const char* a1 = cA + (size_t)(t + 1) * kstep;
            const char* a2 = last ? nA : cA + (size_t)(t + 2) * kstep; const char* b2 = last ? nB : cB + (size_t)(t + 2) * kstep;
            const char* a3 = a2 + kstep; const char* b3 = b2 + kstep;
            if (last && has_next) S.a_ready(nxt);
            if constexpr (SP2) {
            PG8_LDB(B0, 0, 0); PG8_LDB(B1, 0, 1); PG8_SCHED; PG8_LDA(At, 0, 0); PG8_STAGE(PG8_SA(1, 1), a1 + hstep, voffA);
            PG8_WAIT_V(8); PG8_WAIT_L(0); PG8_BAR; PG8_MMA(0, 0, At, B0); PG8_MMA(0, 1, At, B1); PG8_BAR; PG8_SCHED;
            PG8_LDA(At, 0, 1); PG8_STAGE(PG8_SB(0, 0), b2, voffB); PG8_STAGE(PG8_SB(0, 1), b2 + hstep, voffB); PG8_STAGE(PG8_SA(0, 0), a2, voffA);
            PG8_WAIT_V(8); PG8_WAIT_L(0); PG8_BAR; PG8_MMA(1, 0, At, B0); PG8_MMA(1, 1, At, B1); PG8_BAR; PG8_SCHED;
            PG8_LDB(B0, 1, 0); PG8_LDB(B1, 1, 1); PG8_SCHED; PG8_LDA(At, 1, 0); PG8_STAGE(PG8_SA(0, 1), a2 + hstep, voffA);
            PG8_WAIT_V(8); PG8_WAIT_L(0); PG8_BAR; PG8_MMA(0, 0, At, B0); PG8_MMA(0, 1, At, B1); PG8_BAR; PG8_SCHED;
            PG8_LDA(At, 1, 1); PG8_STAGE(PG8_SB(1, 0), b3, voffB); PG8_STAGE(PG8_SB(1, 1), b3 + hstep, voffB); PG8_STAGE(PG8_SA(1, 0), a3, voffA);
            PG8_WAIT_V(8); PG8_WAIT_L(0); PG8_BAR; PG8_MMA(1, 0, At, B0); PG8_MMA(1, 1, At, B1); PG8_BAR; PG8_SCHED;
            } else {
            PG8_LDB(B0, 0, 0); PG8_SCHED; PG8_LDA(At, 0, 0); PG8_STAGE(PG8_SA(1, 1), a1 + hstep, voffA);
            PG8_WAIT_L(8); PG8_BAR; PG8_WAIT_L(0); PG8_MMA(0, 0, At, B0); PG8_BAR; PG8_SCHED;
            PG8_LDB(B1, 0, 1); PG8_STAGE(PG8_SB(0, 0), b2, voffB);
            PG8_BAR; PG8_WAIT_L(0); PG8_MMA(0, 1, At, B1); PG8_BAR;
            PG8_LDA(At, 0, 1); PG8_STAGE(PG8_SA(0, 0), a2, voffA);
            PG8_BAR; PG8_WAIT_L(0); PG8_MMA(1, 0, At, B0); PG8_BAR; PG8_SCHED;
            PG8_STAGE(PG8_SB(0, 1), b2 + hstep, voffB);
            PG8_WAIT_V(6); PG8_BAR; PG8_MMA(1, 1, At, B1); PG8_BAR;
            PG8_LDB(B0, 1, 0); PG8_SCHED; PG8_LDA(At, 1, 0); PG8_STAGE(PG8_SA(0, 1), a2 + hstep, voffA);
            PG8_WAIT_L(8); PG8_BAR; PG8_WAIT_L(0); PG8_MMA(0, 0, At, B0); PG8_BAR; PG8_SCHED;
            PG8_LDB(B1, 1, 1); PG8_STAGE(PG8_SB(1, 0), b3, voffB);
            PG8_BAR; PG8_WAIT_L(0); PG8_MMA(0, 1, At, B1); PG8_BAR;
            PG8_LDA(At, 1, 1); PG8_STAGE(PG8_SA(1, 0), a3, voffA);
            PG8_BAR; PG8_WAIT_L(0); PG8_MMA(1, 0, At, B0); PG8_BAR; PG8_SCHED;
            PG8_STAGE(PG8_SB(1, 1), b3 + hstep, voffB);
            PG8_WAIT_V(6); PG8_BAR; PG8_MMA(1, 1, At, B1); PG8_BAR;
            }
        }
        if constexpr (ALIGN_EPI) { if (wr == 0) PG8_BAR; }
        if constexpr (!Epi::AFTER_DRAIN) { E(acc, cur, wr, wc, fr, fq); S.done(cur); }
        if (!has_next) break;
#pragma unroll
        for (int a = 0; a < 2; ++a)
#pragma unroll
            for (int b = 0; b < 2; ++b)
#pragma unroll
                for (int m = 0; m < 4; ++m)
#pragma unroll
                    for (int n = 0; n < 2; ++n) acc[a][b][m][n] = (f32x4){0.f, 0.f, 0.f, 0.f};
        cur = nxt; cA = nA; cB = nB; ++ui;
        if constexpr (ALIGN_EPI) { if (wr == 1) PG8_BAR; }
    }
    PG8_WAIT_V(0);
    if constexpr (!ALIGN_EPI) { if (wr == 0) PG8_BAR; }
    PG8_BAR;
    if constexpr (Epi::AFTER_DRAIN) { E.fused(acc, cur, wr, wc, fr, fq, lds, wid, lane); S.done(cur); }
#undef PG8_SA
#undef PG8_SB
#undef PG8_STAGE
#undef PG8_LDA
#undef PG8_LDB
#undef PG8_MMA
#undef PG8_WAIT_V
#undef PG8_WAIT_L
#undef PG8_BAR
#undef PG8_SCHED
}
}

#define LAS __attribute__((address_space(3)))
typedef unsigned short bf16_t;
typedef short bf16x8 __attribute__((ext_vector_type(8)));
typedef float f32x4 __attribute__((ext_vector_type(4)));
typedef float f32x2 __attribute__((ext_vector_type(2)));
typedef unsigned u32x4 __attribute__((ext_vector_type(4)));
typedef unsigned u32x2 __attribute__((ext_vector_type(2)));

constexpr int SEQ = 16384, DM = 2048, INW = 5392, NH = 5632;
constexpr int CQA = 0, CKA = 1024, CVA = 1152, CZA = 1280, CQG = 2304, CKG = 2816, CVG = 3328, CZG = 4352, CLR = 5376;
constexpr int GC = 128, NCH = SEQ / GC;
constexpr int NTHREADS = 512, NWAVES = 8;
constexpr int LDS_BYTES = 147456;
constexpr float LN_EPS = 1e-5f, RMS_EPS = 1e-5f;
constexpr size_t MiB = 1u << 20;
constexpr size_t WS_XB = 0;
constexpr size_t WS_WIN = 64 * MiB;
constexpr size_t WS_WOUT = 88 * MiB;
constexpr size_t WS_ROPE = 96 * MiB;
constexpr size_t WS_TOT = 100 * MiB;
constexpr size_t WS_H = 104 * MiB;
constexpr size_t WS_Y = 280 * MiB;
constexpr size_t WS_KV = 344 * MiB;
constexpr size_t WS_SC = 408 * MiB;
constexpr size_t WS_CTL = 440 * MiB, CTL_BYTES = 16384;
constexpr size_t WS_END = 441 * MiB;
constexpr int MISC_OFF = LDS_BYTES - 64;

__constant__ float INVF[32] = {1.000000000e+00f,7.498942018e-01f,5.623413324e-01f,4.216965139e-01f,3.162277639e-01f,2.371373922e-01f,1.778279394e-01f,1.333521456e-01f,1.000000015e-01f,7.498941571e-02f,5.623412877e-02f,4.216964915e-02f,3.162277862e-02f,2.371373586e-02f,1.778279431e-02f,1.333521493e-02f,9.999999776e-03f,7.498942316e-03f,5.623413250e-03f,4.216964822e-03f,3.162277862e-03f,2.371373819e-03f,1.778279431e-03f,1.333521446e-03f,1.000000047e-03f,7.498941850e-04f,5.623413017e-04f,4.216965463e-04f,3.162277862e-04f,2.371373848e-04f,1.778279402e-04f,1.333521504e-04f};

struct Params {
    const float* x; const float* w_in; const float* w_gk_up; const float* b_gk; const float* sinks; const float* gla_norm_w; const float* w_out; const float* ln_g; const float* ln_b;
    float* out; unsigned char* ws;
};

typedef __bf16 bf16x2_t __attribute__((ext_vector_type(2)));
__device__ __forceinline__ unsigned pk_bf16(float lo, float hi) { const f32x2 v = {lo, hi}; return __builtin_bit_cast(unsigned, __builtin_convertvector(v, bf16x2_t)); }
__device__ __forceinline__ float bflo(unsigned w) { return __uint_as_float(w << 16); }
__device__ __forceinline__ float bfhi(unsigned w) { return __uint_as_float(w & 0xffff0000u); }
__device__ __forceinline__ float bf2f(bf16_t v) { return __uint_as_float((unsigned)v << 16); }
__device__ __forceinline__ float silu(float z) { return z * __builtin_amdgcn_rcpf(1.f + __builtin_amdgcn_exp2f(z * -1.4426950408889634f)); }
__device__ __forceinline__ f32x4 mfma16(bf16x8 a, bf16x8 b, f32x4 c) { return __builtin_amdgcn_mfma_f32_16x16x32_bf16(a, b, c, 0, 0, 0); }
#define LDS_WAIT() asm volatile("s_waitcnt lgkmcnt(0)" ::: "memory")


#define RLX_AGENT __ATOMIC_RELAXED, __HIP_MEMORY_SCOPE_AGENT
#define XB_TMO      128
#define XB_XCNT(j)  (256  + 64 * (j))
#define XB_XSUB(j)  (1280 + 64 * (j))
#define XB_XGEN(j)  (2304 + 64 * (j))
#define XB_TOP      3328
#define XB_TOPGEN   3392
#define XCD_BAR_WORDS 3456
#define XB_SPIN_CAP (1u << 18)

__device__ __forceinline__ unsigned xb_ld(unsigned* p)              { return __hip_atomic_load(p, __ATOMIC_RELAXED, __HIP_MEMORY_SCOPE_AGENT); }
__device__ __forceinline__ unsigned xb_add(unsigned* p, unsigned v) { return __hip_atomic_fetch_add(p, v, __ATOMIC_RELAXED, __HIP_MEMORY_SCOPE_AGENT); }
__device__ __forceinline__ unsigned xb_xcc_id() { return (unsigned)__builtin_amdgcn_s_getreg((3 << 11) | 20) & 0xFu; }
#define XB_SPIN(cond, bar) do { unsigned _sp = 0; while (cond) { __builtin_amdgcn_s_sleep(1); \
    if ((++_sp & 255u) == 0u) { if (xb_ld(&(bar)[XB_TMO])) break; if (_sp > XB_SPIN_CAP) { atomicAdd(&(bar)[XB_TMO], 1u); break; } } } } while (0)

struct XcdBarrier {
    unsigned* bar; unsigned x;
    volatile LAS unsigned* st;
};

__device__ __forceinline__ XcdBarrier xcd_barrier_post(unsigned* bar, volatile LAS unsigned* st) {
    XcdBarrier b; b.bar = bar; b.x = xb_xcc_id(); b.st = st;
    if (threadIdx.x == 0) (void)xb_add(&bar[XB_XCNT(b.x)], 1u);
    return b;
}
__device__ __forceinline__ void xcd_barrier_complete(unsigned* bar, unsigned x, unsigned& nloc, unsigned& nx) {
    const unsigned G = gridDim.x * gridDim.y * gridDim.z;
    unsigned sum, cnt, mine, sp = 0u;
    for (;;) {
        sum = 0u; cnt = 0u; mine = 0u;
#pragma unroll
        for (unsigned j = 0; j < 16; ++j) { const unsigned c = xb_ld(&bar[XB_XCNT(j)]); sum += c; cnt += (c > 0u) ? 1u : 0u; mine = (j == x) ? c : mine; }
        if (sum == G) break;
        __builtin_amdgcn_s_sleep(1);
        if ((++sp & 255u) == 0u) { if (xb_ld(&bar[XB_TMO])) break; if (sp > XB_SPIN_CAP) { atomicAdd(&bar[XB_TMO], 1u); break; } }
    }
    nloc = mine > 0u ? mine : 1u; nx = cnt > 0u ? cnt : 1u;
}

__device__ __forceinline__ void xcd_barrier(const XcdBarrier& b) {
    asm volatile("s_waitcnt vmcnt(0)" ::: "memory");
    __syncthreads();
    if (threadIdx.x == 0) {
        unsigned* bar = b.bar;
        __builtin_amdgcn_s_waitcnt(0);
        unsigned nloc = b.st[0], nx = b.st[1];
        if (nloc == 0u) { xcd_barrier_complete(bar, b.x, nloc, nx); b.st[0] = nloc; b.st[1] = nx; }
        const unsigned old = xb_add(&bar[XB_XSUB(b.x)], 1u);
        const unsigned gen = old / nloc;
        if (old + 1u == (gen + 1u) * nloc) {
            __builtin_amdgcn_fence(__ATOMIC_RELEASE, "agent");
            asm volatile("s_waitcnt vmcnt(0)" ::: "memory");
            const unsigned og = xb_add(&bar[XB_TOP], 1u);
            const unsigned tg = og / nx;
            if (og + 1u == (tg + 1u) * nx) xb_add(&bar[XB_TOPGEN], 1u);
            else XB_SPIN(xb_ld(&bar[XB_TOPGEN]) == tg, bar);
            __builtin_amdgcn_fence(__ATOMIC_ACQUIRE, "agent");
            xb_add(&bar[XB_XGEN(b.x)], 1u);
            asm volatile("s_waitcnt vmcnt(0)" ::: "memory");
        } else {
            XB_SPIN(xb_ld(&bar[XB_XGEN(b.x)]) == gen, bar);
            __builtin_amdgcn_fence(__ATOMIC_ACQUIRE, "agent");
            asm volatile("s_waitcnt vmcnt(0)" ::: "memory");
        }
    }
    __syncthreads();
}

__device__ __forceinline__ void p0_transpose_item(const float* W, int K, int N, int NP, bf16_t* WT, LAS float* scr, int item, int lane) {
    const int nblk = NP / 32, kb = item / nblk, nb = item % nblk, k0 = 64 * kb, n0 = 32 * nb;
    const int ncol = n0 + (lane & 31);
#pragma unroll
    for (int i = 0; i < 32; ++i) { const int kk = 2 * i + (lane >> 5); scr[kk * 33 + (lane & 31)] = (ncol < N) ? W[(size_t)(k0 + kk) * N + ncol] : 0.f; }
    LDS_WAIT(); asm volatile("" ::: "memory");
    const int c = lane & 7;
#pragma unroll
    for (int j = 0; j < 4; ++j) { const int n = (lane >> 3) + 8 * j; const LAS float* s = scr + (8 * c) * 33 + n;
        u32x4 o; o.x = pk_bf16(s[0 * 33], s[1 * 33]); o.y = pk_bf16(s[2 * 33], s[3 * 33]); o.z = pk_bf16(s[4 * 33], s[5 * 33]); o.w = pk_bf16(s[6 * 33], s[7 * 33]);
        *(u32x4*)(WT + (size_t)(n0 + n) * K + k0 + 8 * c) = o; }
    LDS_WAIT(); asm volatile("" ::: "memory");
}

__device__ __forceinline__ void phase_prologue(const Params& p, LAS unsigned char* lds, int tid, int wid, int lane) {
    unsigned char* ws = p.ws;
    const int G = gridDim.x;
    {
        const f32x4* x4 = (const f32x4*)p.x; u32x4* xb = (u32x4*)(ws + WS_XB);
        const size_t n8 = (size_t)SEQ * DM / 8, stride = (size_t)G * NTHREADS;
        for (size_t i = (size_t)blockIdx.x * NTHREADS + tid; i < n8; i += 4 * stride) {
            f32x4 a[4], b[4];
#pragma unroll
            for (int u = 0; u < 4; ++u) { const size_t idx = i + u * stride; if (idx < n8) { a[u] = __builtin_nontemporal_load(x4 + 2 * idx); b[u] = __builtin_nontemporal_load(x4 + 2 * idx + 1); } }
#pragma unroll
            for (int u = 0; u < 4; ++u) { const size_t idx = i + u * stride; if (idx < n8) {
                u32x4 w; w.x = pk_bf16(a[u].x, a[u].y); w.y = pk_bf16(a[u].z, a[u].w); w.z = pk_bf16(b[u].x, b[u].y); w.w = pk_bf16(b[u].z, b[u].w);
                xb[idx] = w; } }
        }
    }
    {
        LAS float* scr = (LAS float*)(lds + wid * 8448);
        const int gw = blockIdx.x * NWAVES + wid, NGW = G * NWAVES;
        constexpr int I_IN = (DM / 64) * (NH / 32), I_OUT = (DM / 64) * (DM / 32);
        for (int it = gw; it < I_IN + I_OUT; it += NGW) {
            if (it < I_IN) p0_transpose_item(p.w_in, DM, INW, NH, (bf16_t*)(ws + WS_WIN), scr, it, lane);
            else p0_transpose_item(p.w_out, DM, DM, DM, (bf16_t*)(ws + WS_WOUT), scr, it - I_IN, lane);
        }
    }
    {
        float* rope = (float*)(ws + WS_ROPE);
        const int n = SEQ * 32, stride = G * NTHREADS;
        for (int i = blockIdx.x * NTHREADS + tid; i < n; i += stride) {
            const int pos = i >> 5, j = i & 31;
            const float ang = (float)pos * INVF[j];
            const double a = (double)ang;
            const double kq = __builtin_rint(a * 0.63661977236758134308);
            const double y = a - kq * 1.57079632679489661923;
            const double y2 = y * y;
            double sp = -1.0 / 6227020800.0; sp = sp * y2 + 1.0 / 39916800.0; sp = sp * y2 - 1.0 / 362880.0; sp = sp * y2 + 1.0 / 5040.0; sp = sp * y2 - 1.0 / 120.0; sp = sp * y2 + 1.0 / 6.0;
            const double sn = y - y * y2 * sp;
            double cp = 1.0 / 87178291200.0; cp = cp * y2 - 1.0 / 479001600.0; cp = cp * y2 + 1.0 / 3628800.0; cp = cp * y2 - 1.0 / 40320.0; cp = cp * y2 + 1.0 / 720.0; cp = cp * y2 - 1.0 / 24.0; cp = cp * y2 + 0.5;
            const double cs = 1.0 - y2 * cp;
            const int q = ((int)kq) & 3;
            const double s_o = (q == 0) ? sn : (q == 1) ? cs : (q == 2) ? -sn : -cs;
            const double c_o = (q == 0) ? cs : (q == 1) ? -sn : (q == 2) ? -cs : sn;
            rope[(size_t)pos * 64 + j] = (float)c_o; rope[(size_t)pos * 64 + 32 + j] = (float)s_o;
        }
    }
}

typedef short s16x4 __attribute__((ext_vector_type(4)));
constexpr int A_KLD = 72, A_VLD = 72;
__device__ __forceinline__ void rope8v(const u32x4 a, const u32x4 b, const f32x4 c0, const f32x4 c1, const f32x4 s0, const f32x4 s1, float scale, u32x4& lo, u32x4& hi) {
    const unsigned aw[4] = {a.x, a.y, a.z, a.w}, bw[4] = {b.x, b.y, b.z, b.w};
    const float cs[8] = {c0.x, c0.y, c0.z, c0.w, c1.x, c1.y, c1.z, c1.w}, sn[8] = {s0.x, s0.y, s0.z, s0.w, s1.x, s1.y, s1.z, s1.w};
    unsigned lw[4], hw[4];
#pragma unroll
    for (int i = 0; i < 4; ++i) {
        const float x1a = bflo(aw[i]), x1b = bfhi(aw[i]), x2a = bflo(bw[i]), x2b = bfhi(bw[i]);
        const float o1a = (x1a * cs[2 * i] - x2a * sn[2 * i]) * scale, o1b = (x1b * cs[2 * i + 1] - x2b * sn[2 * i + 1]) * scale;
        const float o2a = (x2a * cs[2 * i] + x1a * sn[2 * i]) * scale, o2b = (x2b * cs[2 * i + 1] + x1b * sn[2 * i + 1]) * scale;
        lw[i] = pk_bf16(o1a, o1b); hw[i] = pk_bf16(o2a, o2b);
    }
    lo = (u32x4){lw[0], lw[1], lw[2], lw[3]}; hi = (u32x4){hw[0], hw[1], hw[2], hw[3]};
}
struct QPre { u32x4 a, b; f32x4 c0, c1, s0, s1; u32x4 z0, z1; };
__device__ __forceinline__ QPre attn_qload(const bf16_t* H, const float* ROPE, int pos, int hq, int fq) {
    QPre q;
    const bf16_t* qp = H + (size_t)pos * NH + CQA + hq * 64 + 8 * fq;
    q.a = *(const u32x4*)qp; q.b = *(const u32x4*)(qp + 32);
    const float* rp = ROPE + (size_t)pos * 64 + 8 * fq;
    q.c0 = *(const f32x4*)rp; q.c1 = *(const f32x4*)(rp + 4); q.s0 = *(const f32x4*)(rp + 32); q.s1 = *(const f32x4*)(rp + 36);
    const bf16_t* zp = H + (size_t)pos * NH + CZA + hq * 64 + 8 * fq;
    q.z0 = *(const u32x4*)zp; q.z1 = *(const u32x4*)(zp + 32);
    return q;
}

__device__ __forceinline__ void attn_unit(const Params& p, LAS unsigned char* lds, int nb, int kvh, int tid, int wid, int lane) {
    asm volatile("" : "+v"(tid), "+v"(lane));
    const bf16_t* H = (const bf16_t*)(p.ws + WS_H); const float* ROPE = (const float*)(p.ws + WS_ROPE); bf16_t* Y = (bf16_t*)(p.ws + WS_Y);
    LAS bf16_t* KL = (LAS bf16_t*)lds; LAS bf16_t* VT = KL + 256 * A_KLD;
    const int fr = lane & 15, fq = lane >> 4;
    const int hq = kvh * 8 + wid;
    u32x4 ka[2], kb[2], vv[4]; f32x4 kc0[2], kc1[2], ks0[2], ks1[2];
#pragma unroll
    for (int j = 0; j < 2; ++j) {
        const int task = tid + NTHREADS * j; const int key = task >> 2, g = task & 3; const int pos = (nb - 1) * 128 + key;
        ka[j] = (u32x4){0u, 0u, 0u, 0u}; kb[j] = ka[j]; kc0[j] = (f32x4){0.f, 0.f, 0.f, 0.f}; kc1[j] = kc0[j]; ks0[j] = kc0[j]; ks1[j] = kc0[j];
        if (pos >= 0) {
            const bf16_t* kp = H + (size_t)pos * NH + CKA + kvh * 64 + 8 * g;
            ka[j] = *(const u32x4*)kp; kb[j] = *(const u32x4*)(kp + 32);
            const float* rp = ROPE + (size_t)pos * 64 + 8 * g;
            kc0[j] = *(const f32x4*)rp; kc1[j] = *(const f32x4*)(rp + 4); ks0[j] = *(const f32x4*)(rp + 32); ks1[j] = *(const f32x4*)(rp + 36);
        }
    }
#pragma unroll
    for (int j = 0; j < 4; ++j) {
        const int task = tid + NTHREADS * j; const int key = task >> 3, dg = task & 7; const int pos = (nb - 1) * 128 + key;
        vv[j] = (u32x4){0u, 0u, 0u, 0u};
        if (pos >= 0) vv[j] = *(const u32x4*)(H + (size_t)pos * NH + CVA + kvh * 64 + 8 * dg);
    }
    const float sink = p.sinks[hq] * 1.4426950408889634f;
    QPre nxt = attn_qload(H, ROPE, nb * 128 + fr, hq, fq);
    __syncthreads();
#pragma unroll
    for (int j = 0; j < 2; ++j) {
        const int task = tid + NTHREADS * j; const int key = task >> 2, g = task & 3;
        u32x4 lo, hi; rope8v(ka[j], kb[j], kc0[j], kc1[j], ks0[j], ks1[j], 1.0f, lo, hi);
        *(LAS u32x4*)(KL + key * A_KLD + 8 * g) = lo; *(LAS u32x4*)(KL + key * A_KLD + 32 + 8 * g) = hi;
    }
#pragma unroll
    for (int j = 0; j < 4; ++j) {
        const int task = tid + NTHREADS * j; const int key = task >> 3, dg = task & 7;
        *(LAS u32x4*)(VT + key * A_VLD + 8 * dg) = vv[j];
    }
    __syncthreads();
#pragma unroll 1
    for (int it = 0; it < 8; ++it) {
        const int pos = nb * 128 + 16 * it + fr;
        const QPre cur = nxt;
        if (it < 7) nxt = attn_qload(H, ROPE, pos + 16, hq, fq);
        bf16x8 qlo, qhi;
        { u32x4 lo, hi; rope8v(cur.a, cur.b, cur.c0, cur.c1, cur.s0, cur.s1, 0.125f * 1.4426950408889634f, lo, hi); qlo = __builtin_bit_cast(bf16x8, lo); qhi = __builtin_bit_cast(bf16x8, hi); }
        f32x4 s[9];
#pragma unroll
        for (int j = 0; j < 9; ++j) {
            const LAS bf16_t* kp = KL + (16 * (it + j) + fr) * A_KLD + 8 * fq;
            const bf16x8 k0 = *(const LAS bf16x8*)kp, k1 = *(const LAS bf16x8*)(kp + 32);
            f32x4 acc = (f32x4){0.f, 0.f, 0.f, 0.f};
            acc = mfma16(k0, qlo, acc); acc = mfma16(k1, qhi, acc);
            s[j] = acc;
        }
#pragma unroll
        for (int r = 0; r < 4; ++r) { s[0][r] = (fr >= 4 * fq + r) ? -INFINITY : s[0][r]; s[8][r] = (4 * fq + r > fr) ? -INFINITY : s[8][r]; }
        if (nb == 0) {
#pragma unroll
            for (int j = 0; j < 8; ++j) if (it + j < 8) s[j] = (f32x4){-INFINITY, -INFINITY, -INFINITY, -INFINITY};
        }
        float m = sink;
#pragma unroll
        for (int j = 0; j < 9; ++j) m = fmaxf(fmaxf(m, fmaxf(s[j][0], s[j][1])), fmaxf(s[j][2], s[j][3]));
        m = fmaxf(m, __shfl_xor(m, 16)); m = fmaxf(m, __shfl_xor(m, 32));
        float l = 0.f;
#pragma unroll
        for (int j = 0; j < 9; ++j)
#pragma unroll
            for (int r = 0; r < 4; ++r) { const float e = __builtin_amdgcn_exp2f(s[j][r] - m); s[j][r] = e; l += e; }
        l += __shfl_xor(l, 16); l += __shfl_xor(l, 32);
        l += __builtin_amdgcn_exp2f(sink - m);
        const float inv = __builtin_amdgcn_rcpf(l);
        f32x4 o[4];
#pragma unroll
        for (int dt = 0; dt < 4; ++dt) o[dt] = (f32x4){0.f, 0.f, 0.f, 0.f};
#pragma unroll
        for (int pp = 0; pp < 5; ++pp) {
            const int j0 = 2 * pp, j1 = (pp < 4) ? 2 * pp + 1 : 2 * pp;
            u32x4 pw; pw.x = pk_bf16(s[j0][0], s[j0][1]); pw.y = pk_bf16(s[j0][2], s[j0][3]);
            if (pp < 4) { pw.z = pk_bf16(s[j1][0], s[j1][1]); pw.w = pk_bf16(s[j1][2], s[j1][3]); } else { pw.z = 0u; pw.w = 0u; }
            const bf16x8 pf = __builtin_bit_cast(bf16x8, pw);
#pragma unroll
            for (int dt = 0; dt < 4; ++dt) {
                const LAS bf16_t* vp = VT + (4 * fq + (fr >> 2)) * A_VLD + 32 * (dt >> 1) + 8 * (fr & 3) + 4 * (dt & 1);
                const s16x4 v0 = __builtin_amdgcn_ds_read_tr16_b64_v4i16((LAS s16x4*)(vp + 16 * (it + j0) * A_VLD)), v1 = __builtin_amdgcn_ds_read_tr16_b64_v4i16((LAS s16x4*)(vp + 16 * (it + j1) * A_VLD));
                o[dt] = mfma16((bf16x8){v0[0], v0[1], v0[2], v0[3], v1[0], v1[1], v1[2], v1[3]}, pf, o[dt]);
            }
        }
#pragma unroll
        for (int hh = 0; hh < 2; ++hh) {
            const int d0 = 32 * hh + 8 * fq; const u32x4 zw = hh ? cur.z1 : cur.z0; const f32x4 oa = o[2 * hh], ob = o[2 * hh + 1];
            u32x4 w;
            w.x = pk_bf16(oa[0] * inv * silu(bflo(zw.x)), oa[1] * inv * silu(bfhi(zw.x))); w.y = pk_bf16(oa[2] * inv * silu(bflo(zw.y)), oa[3] * inv * silu(bfhi(zw.y)));
            w.z = pk_bf16(ob[0] * inv * silu(bflo(zw.z)), ob[1] * inv * silu(bfhi(zw.z))); w.w = pk_bf16(ob[2] * inv * silu(bflo(zw.w)), ob[3] * inv * silu(bfhi(zw.w)));
            *(u32x4*)(Y + (size_t)pos * DM + hq * 64 + d0) = w;
        }
    }
}

constexpr int G_LD = 136;
constexpr int GL_Q = 0, GL_K = 34816, GL_V = 69632, GL_G = 139264, GL_P = 143360;
static_assert(GL_P + 2048 <= MISC_OFF, "GLA LDS map");
struct GlaLoads { u32x2 gkw; u32x4 kw[4]; u32x4 vw[8]; float wub[4]; float bias; };
__device__ __forceinline__ void gla_issue(const Params& p, const bf16_t* H, int t0, int h, int tid, GlaLoads& L) {
    L.gkw = *(const u32x2*)(H + (size_t)(t0 + (tid >> 2)) * NH + CLR + 4 * (tid & 3));
#pragma unroll
    for (int j = 0; j < 4; ++j) { const int idx = tid + NTHREADS * j, tok = idx >> 4, dg = idx & 15; L.kw[j] = *(const u32x4*)(H + (size_t)(t0 + tok) * NH + CKG + h * 128 + 8 * dg); }
#pragma unroll
    for (int j = 0; j < 8; ++j) { const int idx = tid + NTHREADS * j, tok = idx >> 5, dvg = idx & 31; L.vw[j] = *(const u32x4*)(H + (size_t)(t0 + tok) * NH + CVG + h * 256 + 8 * dvg); }
    const int dch = h * 128 + 16 * (tid >> 6) + (tid & 15), fqq = (tid >> 4) & 3;
#pragma unroll
    for (int s = 0; s < 4; ++s) L.wub[s] = p.w_gk_up[(4 * s + fqq) * 512 + dch];
    L.bias = p.b_gk[dch];
}
__device__ __forceinline__ void gla_store_gk(LAS bf16_t* GLb, const GlaLoads& L, int tid) {
    LAS bf16_t* g = GLb + (tid >> 2) * 16 + (tid & 3);
    g[0] = (bf16_t)(L.gkw.x & 0xffffu); g[4] = (bf16_t)(L.gkw.x >> 16); g[8] = (bf16_t)(L.gkw.y & 0xffffu); g[12] = (bf16_t)(L.gkw.y >> 16);
}
constexpr int V_LD = 272;
__device__ __forceinline__ void gla_store_vt(LAS bf16_t* VN, const GlaLoads& L, int tid) {
#pragma unroll
    for (int j = 0; j < 8; ++j) { const int idx = tid + NTHREADS * j, tok = idx >> 5, dvg = idx & 31; *(LAS u32x4*)(VN + tok * V_LD + 8 * dvg) = L.vw[j]; }
}
__device__ __forceinline__ bf16x8 v_frag_tr(const LAS bf16_t* VN, int c, int ks, int lane) {
    const int g = lane >> 4, q = (lane & 15) >> 2, pp = lane & 3;
    const LAS bf16_t* p0 = VN + (32 * ks + 8 * g + q) * V_LD + 16 * c + 4 * pp;
    const s16x4 a = __builtin_amdgcn_ds_read_tr16_b64_v4i16((LAS s16x4*)p0), b = __builtin_amdgcn_ds_read_tr16_b64_v4i16((LAS s16x4*)(p0 + 4 * V_LD));
    return (bf16x8){a[0], a[1], a[2], a[3], b[0], b[1], b[2], b[3]};
}
__device__ __forceinline__ bf16x8 v_frag_tr8(const LAS bf16_t* VN, int cb, int ks, int lane) {
    const int g = lane >> 4, q = (lane & 15) >> 2, pp = lane & 3;
    const LAS bf16_t* p0 = VN + (32 * ks + 8 * g + q) * V_LD + cb + 8 * pp;
    const s16x4 a = __builtin_amdgcn_ds_read_tr16_b64_v4i16((LAS s16x4*)p0), b = __builtin_amdgcn_ds_read_tr16_b64_v4i16((LAS s16x4*)(p0 + 4 * V_LD));
    return (bf16x8){a[0], a[1], a[2], a[3], b[0], b[1], b[2], b[3]};
}
__device__ __forceinline__ void gla_decay(const GlaLoads& L, const LAS bf16_t* GLb, int fr, int fq, float (&bc)[8][4], float& btot) {
    float carry = 0.f;
#pragma unroll
    for (int T = 0; T < 8; ++T) {
        const u32x2 gw = *(const LAS u32x2*)(GLb + (16 * T + fr) * 16 + 4 * fq);
        f32x4 acc = (f32x4){L.bias, L.bias, L.bias, L.bias};
        acc = __builtin_amdgcn_mfma_f32_16x16x4f32(bflo(gw.x), L.wub[0], acc, 0, 0, 0);
        acc = __builtin_amdgcn_mfma_f32_16x16x4f32(bfhi(gw.x), L.wub[1], acc, 0, 0, 0);
        acc = __builtin_amdgcn_mfma_f32_16x16x4f32(bflo(gw.y), L.wub[2], acc, 0, 0, 0);
        acc = __builtin_amdgcn_mfma_f32_16x16x4f32(bfhi(gw.y), L.wub[3], acc, 0, 0, 0);
        float cs[4]; float run = 0.f;
#pragma unroll
        for (int r = 0; r < 4; ++r) { const float z2 = acc[r] * 1.4426950408889634f; const float ls2 = fminf(z2, 0.f) - __builtin_amdgcn_logf(1.f + __builtin_amdgcn_exp2f(-fabsf(z2))); run += ls2 * (1.f / 16.f); cs[r] = run; }
        const float t0 = __shfl(run, fr), t1 = __shfl(run, fr + 16), t2 = __shfl(run, fr + 32), t3 = __shfl(run, fr + 48);
        const float base = carry + (fq > 0 ? t0 : 0.f) + (fq > 1 ? t1 : 0.f) + (fq > 2 ? t2 : 0.f);
#pragma unroll
        for (int r = 0; r < 4; ++r) bc[T][r] = base + cs[r];
        carry += (t0 + t1) + (t2 + t3);
    }
    btot = carry;
}

__device__ __forceinline__ void gla_kv_unit(const Params& p, LAS unsigned char* lds, int c, int h, int tid, int wid, int lane) {
    asm volatile("" : "+v"(tid), "+v"(lane));
    const bf16_t* H = (const bf16_t*)(p.ws + WS_H);
    LAS bf16_t* KN = (LAS bf16_t*)(lds + GL_Q);
    LAS bf16_t* KT = (LAS bf16_t*)(lds + GL_K);
    LAS bf16_t* VT = (LAS bf16_t*)(lds + GL_V);
    LAS bf16_t* GLb = (LAS bf16_t*)(lds + GL_G);
    const int t0 = c * GC, fr = lane & 15, fq = lane >> 4, d = 16 * wid + fr;
    GlaLoads L; gla_issue(p, H, t0, h, tid, L);
    __syncthreads();
    gla_store_gk(GLb, L, tid);
#pragma unroll
    for (int j = 0; j < 4; ++j) { const int idx = tid + NTHREADS * j, tok = idx >> 4, dg = idx & 15; *(LAS u32x4*)(KN + tok * G_LD + 8 * dg) = L.kw[j]; }
    gla_store_vt(VT, L, tid);
    __syncthreads();
    {
        float bc[8][4], btot;
        gla_decay(L, GLb, fr, fq, bc, btot);
#pragma unroll
        for (int T = 0; T < 8; ++T) {
            const s16x4 kv4 = __builtin_amdgcn_ds_read_tr16_b64_v4i16((LAS s16x4*)(KN + (16 * T + 4 * fq + (fr >> 2)) * G_LD + 16 * wid + 4 * (fr & 3)));
            float kt[4];
#pragma unroll
            for (int r = 0; r < 4; ++r) kt[r] = bf2f((bf16_t)kv4[r]) * __builtin_amdgcn_exp2f(-bc[T][r]);
            u32x2 w; w.x = pk_bf16(kt[0], kt[1]); w.y = pk_bf16(kt[2], kt[3]);
            *(LAS u32x2*)(KT + d * G_LD + 16 * T + 4 * fq) = w;
        }
        if (fq == 0) ((float*)(p.ws + WS_TOT))[(c * 4 + h) * 128 + d] = __builtin_amdgcn_exp2f(btot);
    }
    __syncthreads();
    bf16_t* KV = (bf16_t*)(p.ws + WS_KV) + (size_t)(c * 4 + h) * 32768;
#pragma unroll
    for (int jv = 0; jv < 2; ++jv) {
        const int dv0 = 32 * wid + 16 * jv;
        bf16x8 vf[4];
#pragma unroll
        for (int ks = 0; ks < 4; ++ks) vf[ks] = v_frag_tr(VT, 2 * wid + jv, ks, lane);
#pragma unroll
        for (int m = 0; m < 4; ++m) {
            f32x4 acc0 = (f32x4){0.f, 0.f, 0.f, 0.f}, acc1 = acc0;
#pragma unroll
            for (int ks = 0; ks < 4; ++ks) {
                const LAS bf16_t* kp = KT + (32 * m + 8 * (fr >> 2) + (fr & 3)) * G_LD + 32 * ks + 8 * fq;
                acc0 = mfma16(*(const LAS bf16x8*)kp, vf[ks], acc0); acc1 = mfma16(*(const LAS bf16x8*)(kp + 4 * G_LD), vf[ks], acc1);
            }
            u32x4 w; w.x = pk_bf16(acc0[0], acc0[1]); w.y = pk_bf16(acc0[2], acc0[3]); w.z = pk_bf16(acc1[0], acc1[1]); w.w = pk_bf16(acc1[2], acc1[3]);
            *(u32x4*)(KV + (size_t)(dv0 + fr) * 128 + 32 * m + 8 * fq) = w;
        }
    }
}

__device__ __forceinline__ void phase_scan(const Params& p, int tid) {
    const bf16_t* KV = (const bf16_t*)(p.ws + WS_KV); const float* TOT = (const float*)(p.ws + WS_TOT); bf16_t* SC = (bf16_t*)(p.ws + WS_SC);
    for (int e = blockIdx.x * NTHREADS + tid; e < 131072; e += gridDim.x * NTHREADS) {
        const int h = e >> 15, dk = e & 127;
        float s = 0.f;
        for (int c0 = 0; c0 < NCH; c0 += 16) {
            float kv[16], tt[16];
#pragma unroll
            for (int j = 0; j < 16; ++j) { kv[j] = bf2f(KV[(size_t)(c0 + j) * 131072 + e]); tt[j] = TOT[(c0 + j) * 512 + h * 128 + dk]; }
#pragma unroll
            for (int j = 0; j < 16; ++j) { SC[(size_t)(c0 + j) * 131072 + e] = (bf16_t)(pk_bf16(s, 0.f) & 0xffffu); s = tt[j] * (s + kv[j]); }
        }
    }
}

__device__ __forceinline__ void gla_out_unit(const Params& p, LAS unsigned char* lds, int c, int h, int tid, int wid, int lane) {
    asm volatile("" : "+v"(tid), "+v"(lane));
    const bf16_t* H = (const bf16_t*)(p.ws + WS_H); bf16_t* Y = (bf16_t*)(p.ws + WS_Y);
    LAS bf16_t* QL = (LAS bf16_t*)(lds + GL_Q);
    LAS bf16_t* KL = (LAS bf16_t*)(lds + GL_K);
    LAS bf16_t* VT = (LAS bf16_t*)(lds + GL_V);
    LAS bf16_t* GLb = (LAS bf16_t*)(lds + GL_G); LAS float* RS = (LAS float*)(lds + GL_G);
    const int t0 = c * GC, fr = lane & 15, fq = lane >> 4, d = 16 * wid + fr;
    GlaLoads L; gla_issue(p, H, t0, h, tid, L);
    u32x4 qw[4];
#pragma unroll
    for (int j = 0; j < 4; ++j) { const int idx = tid + NTHREADS * j, tok = idx >> 4, dg = idx & 15; qw[j] = *(const u32x4*)(H + (size_t)(t0 + tok) * NH + CQG + h * 128 + 8 * dg); }
    const bf16_t* SC = (const bf16_t*)(p.ws + WS_SC) + (size_t)(c * 4 + h) * 32768;
    bf16x8 sf[2][4];
#pragma unroll
    for (int jv = 0; jv < 2; ++jv)
#pragma unroll
        for (int ks = 0; ks < 4; ++ks) sf[jv][ks] = *(const bf16x8*)(SC + (size_t)(32 * wid + 8 * (fr >> 2) + 4 * jv + (fr & 3)) * 128 + 32 * ks + 8 * fq);
    __syncthreads();
    gla_store_gk(GLb, L, tid);
#pragma unroll
    for (int j = 0; j < 4; ++j) { const int idx = tid + NTHREADS * j, tok = idx >> 4, dg = idx & 15; *(LAS u32x4*)(QL + tok * G_LD + 8 * dg) = qw[j]; *(LAS u32x4*)(KL + tok * G_LD + 8 * dg) = L.kw[j]; }
    gla_store_vt(VT, L, tid);
    __syncthreads();
    {
        float bc[8][4], btot;
        gla_decay(L, GLb, fr, fq, bc, btot);
#pragma unroll
        for (int T = 0; T < 8; ++T) {
            const int ta = (16 * T + 4 * fq + (fr >> 2)) * G_LD + 16 * wid + 4 * (fr & 3);
            const s16x4 q4 = __builtin_amdgcn_ds_read_tr16_b64_v4i16((LAS s16x4*)(QL + ta)), k4 = __builtin_amdgcn_ds_read_tr16_b64_v4i16((LAS s16x4*)(KL + ta));
#pragma unroll
            for (int r = 0; r < 4; ++r) {
                const float e = __builtin_amdgcn_exp2f(bc[T][r]); const int o = (16 * T + 4 * fq + r) * G_LD + d;
                const float qv = bf2f((bf16_t)q4[r]) * 0.08838834764831845f * e;
                const float kv = bf2f((bf16_t)k4[r]) * __builtin_amdgcn_rcpf(e);
                QL[o] = (bf16_t)(pk_bf16(qv, 0.f) & 0xffffu);
                KL[o] = (bf16_t)(pk_bf16(kv, 0.f) & 0xffffu);
            }
        }
    }
    __syncthreads();
    f32x4 at[8];
    {
        bf16x8 qf[4];
#pragma unroll
        for (int ks = 0; ks < 4; ++ks) qf[ks] = *(const LAS bf16x8*)(QL + (16 * wid + fr) * G_LD + 32 * ks + 8 * fq);
#pragma unroll
        for (int jt = 0; jt < 8; ++jt) {
            f32x4 acc = (f32x4){0.f, 0.f, 0.f, 0.f};
            if (jt <= wid) {
#pragma unroll
                for (int ks = 0; ks < 4; ++ks) { const bf16x8 kf = *(const LAS bf16x8*)(KL + (16 * jt + fr) * G_LD + 32 * ks + 8 * fq); acc = mfma16(kf, qf[ks], acc); }
                if (jt == wid) {
#pragma unroll
                    for (int r = 0; r < 4; ++r) acc[r] = (4 * fq + r <= fr) ? acc[r] : 0.f;
                }
            }
            at[jt] = acc;
        }
    }
    __syncthreads();
#pragma unroll
    for (int jt = 0; jt < 8; ++jt) { u32x2 w; w.x = pk_bf16(at[jt][0], at[jt][1]); w.y = pk_bf16(at[jt][2], at[jt][3]); *(LAS u32x2*)(KL + (16 * wid + fr) * G_LD + 16 * jt + 4 * fq) = w; }
    __syncthreads();
    u32x4 zw[8];
#pragma unroll
    for (int i = 0; i < 8; ++i) zw[i] = *(const u32x4*)(H + (size_t)(t0 + 16 * i + fr) * NH + CZG + h * 256 + 32 * wid + 8 * fq);
    bf16x8 vf[2][4];
#pragma unroll
    for (int jv = 0; jv < 2; ++jv)
#pragma unroll
        for (int ks = 0; ks < 4; ++ks) vf[jv][ks] = v_frag_tr8(VT, 32 * wid + 4 * jv, ks, lane);
    f32x4 o[8][2];
#pragma unroll
    for (int i = 0; i < 8; ++i) {
        bf16x8 af[4], qf[4];
#pragma unroll
        for (int ks = 0; ks < 4; ++ks) { af[ks] = *(const LAS bf16x8*)(KL + (16 * i + fr) * G_LD + 32 * ks + 8 * fq); qf[ks] = *(const LAS bf16x8*)(QL + (16 * i + fr) * G_LD + 32 * ks + 8 * fq); }
        float ssp = 0.f;
#pragma unroll
        for (int jv = 0; jv < 2; ++jv) {
            f32x4 acc = (f32x4){0.f, 0.f, 0.f, 0.f};
#pragma unroll
            for (int ks = 0; ks < 4; ++ks) if (ks <= i / 2) acc = mfma16(vf[jv][ks], af[ks], acc);
#pragma unroll
            for (int ks = 0; ks < 4; ++ks) acc = mfma16(sf[jv][ks], qf[ks], acc);
            o[i][jv] = acc;
            ssp += (acc[0] * acc[0] + acc[1] * acc[1]) + (acc[2] * acc[2] + acc[3] * acc[3]);
        }
        ssp += __shfl_xor(ssp, 16); ssp += __shfl_xor(ssp, 32);
        if (fq == 0) RS[wid * 128 + 16 * i + fr] = ssp;
    }
    __syncthreads();
    const f32x4 nw0 = *(const f32x4*)(p.gla_norm_w + 32 * wid + 8 * fq), nw1 = *(const f32x4*)(p.gla_norm_w + 32 * wid + 8 * fq + 4);
#pragma unroll
    for (int i = 0; i < 8; ++i) {
        float tot = 0.f;
#pragma unroll
        for (int w = 0; w < 8; ++w) tot += RS[w * 128 + 16 * i + fr];
        const float rstd = __builtin_amdgcn_rsqf(tot * (1.f / 256.f) + RMS_EPS);
        const int tok = t0 + 16 * i + fr;
        const u32x4 z = zw[i]; const f32x4 a = o[i][0], b = o[i][1];
        u32x4 w;
        w.x = pk_bf16(a[0] * rstd * nw0.x * silu(bflo(z.x)), a[1] * rstd * nw0.y * silu(bfhi(z.x))); w.y = pk_bf16(a[2] * rstd * nw0.z * silu(bflo(z.y)), a[3] * rstd * nw0.w * silu(bfhi(z.y)));
        w.z = pk_bf16(b[0] * rstd * nw1.x * silu(bflo(z.z)), b[1] * rstd * nw1.y * silu(bfhi(z.z))); w.w = pk_bf16(b[2] * rstd * nw1.z * silu(bflo(z.w)), b[3] * rstd * nw1.w * silu(bfhi(z.w)));
        *(u32x4*)(Y + (size_t)tok * DM + 1024 + h * 256 + 32 * wid + 8 * fq) = w;
    }
}

__device__ __forceinline__ void phase_ln(const Params& p, int wid, int lane) {
    const int gw = blockIdx.x * NWAVES + wid, NGW = gridDim.x * NWAVES;
    f32x4 gg[8], bb[8];
#pragma unroll
    for (int j = 0; j < 8; ++j) { gg[j] = *((const f32x4*)p.ln_g + lane + 64 * j); bb[j] = *((const f32x4*)p.ln_b + lane + 64 * j); }
    for (int row = gw; row < SEQ; row += NGW) {
        f32x4* rp = (f32x4*)(p.out + (size_t)row * DM) + lane;
        const u32x2* xp = (const u32x2*)((const bf16_t*)(p.ws + WS_XB) + (size_t)row * DM) + lane;
        const u32x2* yp = (const u32x2*)((const bf16_t*)(p.ws + WS_KV) + (size_t)row * DM) + lane;
        f32x4 v[8]; u32x2 xw[8], yw[8]; float s = 0.f;
#pragma unroll
        for (int j = 0; j < 8; ++j) { xw[j] = xp[64 * j]; yw[j] = yp[64 * j]; }
#pragma unroll
        for (int j = 0; j < 8; ++j) { v[j] = (f32x4){bflo(xw[j].x), bfhi(xw[j].x), bflo(xw[j].y), bfhi(xw[j].y)} * 1.189207115002721f + (f32x4){bflo(yw[j].x), bfhi(yw[j].x), bflo(yw[j].y), bfhi(yw[j].y)}; s += (v[j].x + v[j].y) + (v[j].z + v[j].w); }
#pragma unroll
        for (int o = 1; o < 64; o <<= 1) s += __shfl_xor(s, o);
        const float mean = s * (1.f / DM); float q = 0.f;
#pragma unroll
        for (int j = 0; j < 8; ++j) { v[j] = v[j] - mean; q += (v[j].x * v[j].x + v[j].y * v[j].y) + (v[j].z * v[j].z + v[j].w * v[j].w); }
#pragma unroll
        for (int o = 1; o < 64; o <<= 1) q += __shfl_xor(q, o);
        const float rstd = 1.0f / sqrtf(q * (1.f / DM) + LN_EPS);
#pragma unroll
        for (int j = 0; j < 8; ++j) rp[64 * j] = v[j] * rstd * gg[j] + bb[j];
    }
}

struct OrderG1 {
    pg8::StaticOrder S; int deferred, c, Gg;
    __device__ void init(int G, int c_, int deferred_) { deferred = deferred_; c = c_; Gg = G / 2; S.init(SEQ, 20 * 256, G, c_); }
    __device__ bool next(int i, pg8::Unit& u) const {
        if (deferred) { if (c >= Gg) return false; const int L = c + i * Gg; if (L >= 128) return false; u.pm = L >> 1; u.pn = 19 + (L & 1); return true; }
        if (!S.next(i, u)) return false; if (u.pn == 19) u.pn = 21; return true;
    }
    __device__ __forceinline__ void a_ready(const pg8::Unit&) const {}
    __device__ __forceinline__ void done(const pg8::Unit&) const {}
};

__global__ void __launch_bounds__(NTHREADS, 2) hymba_mega(Params p) {
    extern __shared__ __attribute__((aligned(16))) unsigned char lds_raw[];
    LAS unsigned char* lds = (LAS unsigned char*)lds_raw;
    cg::grid_group grid = cg::this_grid();
    const int tid = threadIdx.x, lane = tid & 63, wid = __builtin_amdgcn_readfirstlane(tid >> 6);
    const int G = gridDim.x;
    volatile LAS unsigned* MISC = (volatile LAS unsigned*)(lds + MISC_OFF);
    if (tid < 16) MISC[tid] = 0u;
    __syncthreads();
    const XcdBarrier bar = xcd_barrier_post((unsigned*)(p.ws + WS_CTL), MISC);
    if (p.ws == nullptr) grid.sync();

    phase_prologue(p, lds, tid, wid, lane);
    xcd_barrier(bar);
    {
        pg8::Gemm g{(const bf16_t*)(p.ws + WS_XB), (const bf16_t*)(p.ws + WS_WIN), SEQ, NH, DM}; OrderG1 S; S.init(G, (int)blockIdx.x, 0);
        pg8::EpiBf16 E{(bf16_t*)(p.ws + WS_H), NH};
        pg8::gemm_phase<pg8::EpiBf16, OrderG1, true, true>(lds, g, S, E);
    }
    xcd_barrier(bar);
    {
        const int Gg = G / 2;
        if ((int)blockIdx.x < Gg) {
            pg8::Gemm g{(const bf16_t*)(p.ws + WS_XB), (const bf16_t*)(p.ws + WS_WIN), SEQ, NH, DM}; OrderG1 S; S.init(G, (int)blockIdx.x, 1);
            pg8::EpiBf16 E{(bf16_t*)(p.ws + WS_H), NH};
            pg8::gemm_phase<pg8::EpiBf16, OrderG1, true, true>(lds, g, S, E);
        } else {
            for (int u = (int)blockIdx.x - Gg; u < NCH * 4; u += G - Gg) gla_kv_unit(p, lds, u >> 2, u & 3, tid, wid, lane);
        }
    }
    xcd_barrier(bar);
    phase_scan(p, tid);
    xcd_barrier(bar);
    const bool attn_first = ((blockIdx.x >> 3) & 1) != 0;
    for (int u = attn_first ? (int)blockIdx.x : 256; u < 256; u += G) attn_unit(p, lds, u >> 1, u & 1, tid, wid, lane);
    for (int u = blockIdx.x; u < NCH * 4; u += G) gla_out_unit(p, lds, u >> 2, u & 3, tid, wid, lane);
    for (int u = attn_first ? 256 : (int)blockIdx.x; u < 256; u += G) attn_unit(p, lds, u >> 1, u & 1, tid, wid, lane);
    xcd_barrier(bar);
    {
        pg8::Gemm g{(const bf16_t*)(p.ws + WS_Y), (const bf16_t*)(p.ws + WS_WOUT), SEQ, DM, DM}; pg8::StaticOrder S; S.init(SEQ, DM, G, (int)blockIdx.x);
        pg8::EpiBf16 E{(bf16_t*)(p.ws + WS_KV), DM};
        pg8::gemm_phase<pg8::EpiBf16, pg8::StaticOrder, true, true>(lds, g, S, E);
    }
    xcd_barrier(bar);
    phase_ln(p, wid, lane);
}

extern "C" void kernel_launch(void* const* d_in, const int* in_sizes, int n_in, void* d_out, int out_size, void* d_ws, size_t ws_size, hipStream_t stream) {
    static int grid = 0;
    if (grid == 0) {
        if (n_in != 9 || out_size != SEQ * DM || ws_size < WS_END) { fprintf(stderr, "kernel_launch: unexpected shapes (n_in %d out %d ws %zu)\n", n_in, out_size, ws_size); grid = -1; return; }
        int dev = 0, cus = 0, per_cu = 0;
        hipGetDevice(&dev); hipDeviceGetAttribute(&cus, hipDeviceAttributeMultiprocessorCount, dev);
        if (hipFuncSetAttribute((const void*)hymba_mega, hipFuncAttributeMaxDynamicSharedMemorySize, LDS_BYTES) != hipSuccess) { fprintf(stderr, "kernel_launch: hipFuncSetAttribute failed\n"); grid = -1; return; }
        if (hipOccupancyMaxActiveBlocksPerMultiprocessor(&per_cu, (const void*)hymba_mega, NTHREADS, LDS_BYTES) != hipSuccess || per_cu < 1) { fprintf(stderr, "kernel_launch: occupancy query failed (%d)\n", per_cu); per_cu = 1; }
        (void)hipGetLastError();
        grid = cus * per_cu;
    }
    if (grid < 0) return;
    Params p{};
    p.x = (const float*)d_in[0]; p.w_in = (const float*)d_in[1]; p.w_gk_up = (const float*)d_in[2]; p.b_gk = (const float*)d_in[3]; p.sinks = (const float*)d_in[4];
    p.gla_norm_w = (const float*)d_in[5]; p.w_out = (const float*)d_in[6]; p.ln_g = (const float*)d_in[7]; p.ln_b = (const float*)d_in[8];
    p.out = (float*)d_out; p.ws = (unsigned char*)d_ws;
    if (hipMemsetAsync((char*)d_ws + WS_CTL, 0, CTL_BYTES, stream) != hipSuccess) { fprintf(stderr, "kernel_launch: memset failed\n"); return; }
    void* args[] = {&p};
    hipError_t e = hipLaunchCooperativeKernel((void*)hymba_mega, dim3(grid), dim3(NTHREADS), args, LDS_BYTES, stream);
    if (e != hipSuccess) fprintf(stderr, "cooperative launch failed: %s (grid %d)\n", hipGetErrorString(e), grid);
}
```

```cpp
#include <hip/hip_runtime.h>
#include <hip/hip_cooperative_groups.h>
#include <cstdio>
#include <cstdint>
namespace cg = cooperative_groups;
namespace pg8 {
#define PG8_LAS __attribute__((address_space(3)))
typedef unsigned short bf16_t;
typedef short bf16x8 __attribute__((ext_vector_type(8)));
typedef float f32x4 __attribute__((ext_vector_type(4)));
typedef unsigned u32x4 __attribute__((ext_vector_type(4)));
constexpr int BM = 256, BK = 64, HALF = 128, HTB = HALF * BK * 2  , STAGE_BYTES = 8 * HTB, NXCD = 8, WGM = 8;

__host__ __device__ __forceinline__ int lds_byte(int r, int c) { const int st = (r >> 4) * 2 + (c >> 5), rr = r & 15, cc = c & 31, ob = rr * 64 + cc * 2; return st * 1024 + (ob ^ (((ob >> 9) & 1) << 5)); }
__host__ __device__ __forceinline__ void stage_rc(int b, int& R, int& C) { const int st = b / 1024, sb = b % 1024, swz = sb ^ (((sb >> 9) & 1) << 5); R = (st >> 1) * 16 + swz / 64; C = (st & 1) * 32 + (swz % 64) / 2; }
__host__ __device__ __forceinline__ int perm32(int rho) { const int n = rho >> 4, i = rho & 15; return 8 * (i >> 2) + 4 * n + (i & 3); }

struct Unit { int pm, pn; };
struct Gemm { const bf16_t* A; const bf16_t* Bt; int M, N, K; };

struct StaticOrder {
    int nM, nN, nwg, G, c;
    __host__ __device__ void init(int M, int N, int G_, int c_) { nM = M / BM; nN = N / BM; nwg = nM * nN; G = G_; c = c_; }
    __host__ __device__ bool next(int i, Unit& u) const {
        const long L = (long)i * G + c; if (L >= nwg) return false;
        int wgid = (int)L; { const int q = nwg / NXCD, r = nwg % NXCD, xcd = wgid % NXCD, off = wgid / NXCD; wgid = (xcd < r ? xcd * (q + 1) : r * (q + 1) + (xcd - r) * q) + off; }
        const int nig = WGM * nN, gid = wgid / nig, fm = gid * WGM, gsz = (nM - fm) < WGM ? (nM - fm) : WGM;
        u.pm = fm + ((wgid % nig) % gsz); u.pn = (wgid % nig) / gsz; return true;
    }
    __device__ __forceinline__ void a_ready(const Unit&) const {}
    __device__ __forceinline__ void done(const Unit&) const {}
};

__device__ __forceinline__ unsigned cvt_pk_bf16(float lo, float hi) { unsigned r; asm volatile("v_cvt_pk_bf16_f32 %0, %1, %2" : "=v"(r) : "v"(lo), "v"(hi)); return r; }
typedef float f32x2 __attribute__((ext_vector_type(2)));
typedef unsigned u32x2 __attribute__((ext_vector_type(2)));
struct EpiBf16 {
    static constexpr bool PERM = true, AFTER_DRAIN = false;
    bf16_t* O; int ldc;
    __device__ __forceinline__ void operator()(const f32x4 (&acc)[2][2][4][2], const Unit& u, int wr, int wc, int fr, int fq) const {
        const int row0 = u.pm * BM + wr * 64 + fr; const int col0 = u.pn * BM + wc * 32 + 8 * fq;
#pragma unroll
        for (int ai = 0; ai < 2; ++ai)
#pragma unroll
            for (int m = 0; m < 4; ++m) { bf16_t* rowp = O + (size_t)(row0 + ai * HALF + m * 16) * ldc + col0;
#pragma unroll
                for (int bj = 0; bj < 2; ++bj) { const f32x4 v0 = acc[ai][bj][m][0], v1 = acc[ai][bj][m][1];
                    u32x4 w; w.x = cvt_pk_bf16(v0[0], v0[1]); w.y = cvt_pk_bf16(v0[2], v0[3]); w.z = cvt_pk_bf16(v1[0], v1[1]); w.w = cvt_pk_bf16(v1[2], v1[3]);
                    *(u32x4*)(rowp + bj * HALF) = w; } }
    }
};
struct EpiResid {
    static constexpr bool PERM = false, AFTER_DRAIN = false;
    const float* x; float* out; int ldc; float alpha;
    __device__ __forceinline__ void operator()(const f32x4 (&acc)[2][2][4][2], const Unit& u, int wr, int wc, int fr, int fq) const {
        const int col0 = u.pn * BM + wc * 32 + 4 * fq;
#pragma unroll
        for (int ai = 0; ai < 2; ++ai)
#pragma unroll
            for (int m = 0; m < 4; ++m) { const int r = ai * HALF + wr * 64 + m * 16 + fr; const size_t off = (size_t)(u.pm * BM + r) * ldc + col0;
#pragma unroll
                for (int bj = 0; bj < 2; ++bj)
#pragma unroll
                    for (int n = 0; n < 2; ++n) { const f32x4 xv = *(const f32x4*)(x + off + bj * HALF + n * 16); const f32x4 o = xv * alpha + acc[ai][bj][m][n];
                        *(f32x4*)(out + off + bj * HALF + n * 16) = o; } }
    }
};
template <class Epi, class Sched, bool ALIGN_EPI = false, bool SP2 = false>
__device__ __forceinline__ void gemm_phase(PG8_LAS unsigned char* lds, const Gemm g, const Sched& S, const Epi& E) {
    int tid = threadIdx.x; asm volatile("" : "+v"(tid));
    const int wid = __builtin_amdgcn_readfirstlane(tid >> 6), lane = tid & 63, wr = wid >> 2, wc = wid & 3, fr = lane & 15, fq = lane >> 4;
    const int K = g.K, nt = K / BK;
    unsigned voffA[2], voffB[2];
#pragma unroll
    for (int i = 0; i < 2; ++i) { int R, C; stage_rc(tid * 16 + i * 8192, R, C); const int Rb = Epi::PERM ? ((R & ~31) + perm32(R & 31)) : R;
        voffA[i] = (unsigned)(R * K + C) * 2u; voffB[i] = (unsigned)(Rb * K + C) * 2u; }
    const size_t kstep = (size_t)(BK * 2);
    const size_t hstep = (size_t)HALF * K * 2;
    const size_t tstep = 2 * hstep;
    const unsigned ldsw = (unsigned)wid * 1024u;
    const int aoff = lds_byte(wr * 64 + fr, fq * 8), boff = lds_byte(wc * 32 + fr, fq * 8);
#define PG8_SA(b, h) (((b) * 2 + (h)) * HTB)
#define PG8_SB(b, h) ((4 + (b) * 2 + (h)) * HTB)
#define PG8_STAGE(bufoff, gbase, voff) do { _Pragma("unroll") for (int _i = 0; _i < 2; ++_i) \
        __builtin_amdgcn_global_load_lds((const unsigned*)((const char*)(gbase) + (voff)[_i]), (PG8_LAS unsigned*)(lds + (bufoff) + ldsw + _i * 8192), 16, 0, 0); } while (0)
#define PG8_LDA(dst, b, h) do { _Pragma("unroll") for (int m = 0; m < 4; ++m) _Pragma("unroll") for (int k = 0; k < 2; ++k) dst[m][k] = *(const PG8_LAS bf16x8*)(lds + PG8_SA(b, h) + aoff + m * 2048 + k * 1024); } while (0)
#define PG8_LDB(dst, b, h) do { _Pragma("unroll") for (int n = 0; n < 2; ++n) _Pragma("unroll") for (int k = 0; k < 2; ++k) dst[n][k] = *(const PG8_LAS bf16x8*)(lds + PG8_SB(b, h) + boff + n * 2048 + k * 1024); } while (0)
#define PG8_MMA(ai, bj, At, Bt) do { __builtin_amdgcn_s_setprio(1); _Pragma("unroll") for (int m = 0; m < 4; ++m) _Pragma("unroll") for (int n = 0; n < 2; ++n) _Pragma("unroll") for (int k = 0; k < 2; ++k) \
        acc[ai][bj][m][n] = __builtin_amdgcn_mfma_f32_16x16x32_bf16(Bt[n][k], At[m][k], acc[ai][bj][m][n], 0, 0, 0); __builtin_amdgcn_s_setprio(0); } while (0)
#define PG8_WAIT_V(n) asm volatile("s_waitcnt vmcnt(" #n ")" ::: "memory")
#define PG8_WAIT_L(n) asm volatile("s_waitcnt lgkmcnt(" #n ")" ::: "memory")
#define PG8_BAR __builtin_amdgcn_s_barrier()
#define PG8_SCHED __builtin_amdgcn_sched_barrier(0)
    Unit cur, nxt; int ui = 0;
    if (!S.next(0, cur)) return;
    f32x4 acc[2][2][4][2];
#pragma unroll
    for (int a = 0; a < 2; ++a)
#pragma unroll
        for (int b = 0; b < 2; ++b)
#pragma unroll
            for (int m = 0; m < 4; ++m)
#pragma unroll
                for (int n = 0; n < 2; ++n) acc[a][b][m][n] = (f32x4){0.f, 0.f, 0.f, 0.f};
    bf16x8 At[4][2], B0[2][2], B1[2][2];
    const char* cA = (const char*)g.A + (size_t)cur.pm * tstep; const char* cB = (const char*)g.Bt + (size_t)cur.pn * tstep;
    S.a_ready(cur);
    if constexpr (SP2) {
        PG8_STAGE(PG8_SB(0, 0), cB, voffB); PG8_STAGE(PG8_SB(0, 1), cB + hstep, voffB); PG8_STAGE(PG8_SA(0, 0), cA, voffA); PG8_STAGE(PG8_SA(0, 1), cA + hstep, voffA);
        if (wr == 1) PG8_BAR;
        PG8_WAIT_V(2); PG8_BAR;
        PG8_STAGE(PG8_SB(1, 0), cB + kstep, voffB); PG8_STAGE(PG8_SA(1, 0), cA + kstep, voffA); PG8_STAGE(PG8_SB(1, 1), cB + hstep + kstep, voffB);
        PG8_WAIT_V(6); PG8_BAR;
    } else {
        PG8_STAGE(PG8_SB(0, 0), cB, voffB); PG8_STAGE(PG8_SA(0, 0), cA, voffA); PG8_STAGE(PG8_SB(0, 1), cB + hstep, voffB); PG8_STAGE(PG8_SA(0, 1), cA + hstep, voffA);
        if (wr == 1) PG8_BAR;
        PG8_WAIT_V(4); PG8_BAR;
        PG8_STAGE(PG8_SB(1, 0), cB + kstep, voffB); PG8_STAGE(PG8_SA(1, 0), cA + kstep, voffA); PG8_STAGE(PG8_SB(1, 1), cB + hstep + kstep, voffB);
        PG8_WAIT_V(6); PG8_BAR;
    }
    for (;;) {
        const bool has_next = S.next(ui + 1, nxt);
        const char* nA = has_next ? (const char*)g.A + (size_t)nxt.pm * tstep : cA; const char* nB = has_next ? (const char*)g.Bt + (size_t)nxt.pn * tstep : cB;
        for (int t = 0; t < nt; t += 2) {
            const bool last = (t == nt - 2);
            const char* a1 = cA + (size_t)(t + 1) * kstep;
            const char* a2 = last ? nA : cA + (size_t)(t + 2) * kstep; const char* b2 = last ? nB : cB + (size_t)(t + 2) * kstep;
            const char* a3 = a2 + kstep; const char* b3 = b2 + kstep;
            if (last && has_next) S.a_ready(nxt);
            if constexpr (SP2) {
            PG8_LDB(B0, 0, 0); PG8_LDB(B1, 0, 1); PG8_SCHED; PG8_LDA(At, 0, 0); PG8_STAGE(PG8_SA(1, 1), a1 + hstep, voffA);
            PG8_WAIT_V(8); PG8_WAIT_L(0); PG8_BAR; PG8_MMA(0, 0, At, B0); PG8_MMA(0, 1, At, B1); PG8_BAR; PG8_SCHED;
            PG8_LDA(At, 0, 1); PG8_STAGE(PG8_SB(0, 0), b2, voffB); PG8_STAGE(PG8_SB(0, 1), b2 + hstep, voffB); PG8_STAGE(PG8_SA(0, 0), a2, voffA);
            PG8_WAIT_V(8); PG8_WAIT_L(0); PG8_BAR; PG8_MMA(1, 0, At, B0); PG8_MMA(1, 1, At, B1); PG8_BAR; PG8_SCHED;
            PG8_LDB(B0, 1, 0); PG8_LDB(B1, 1, 1); PG8_SCHED; PG8_LDA(At, 1, 0); PG8_STAGE(PG8_SA(0, 1), a2 + hstep, voffA);
            PG8_WAIT_V(8); PG8_WAIT_L(0); PG8_BAR; PG8_MMA(0, 0, At, B0); PG8_MMA(0, 1, At, B1); PG8_BAR; PG8_SCHED;
            PG8_LDA(At, 1, 1); PG8_STAGE(PG8_SB(1, 0), b3, voffB); PG8_STAGE(PG8_SB(1, 1), b3 + hstep, voffB); PG8_STAGE(PG8_SA(1, 0), a3, voffA);
            PG8_WAIT_V(8); PG8_WAIT_L(0); PG8_BAR; PG8_MMA(1, 0, At, B0); PG8_MMA(1, 1, At, B1); PG8_BAR; PG8_SCHED;
            } else {
            PG8_LDB(B0, 0, 0); PG8_SCHED; PG8_LDA(At, 0, 0); PG8_STAGE(PG8_SA(1, 1), a1 + hstep, voffA);
            PG8_WAIT_L(8); PG8_BAR; PG8_WAIT_L(0); PG8_MMA(0, 0, At, B0); PG8_BAR; PG8_SCHED;
            PG8_LDB(B1, 0, 1); PG8_STAGE(PG8_SB(0, 0), b2, voffB);
            PG8_BAR; PG8_WAIT_L(0); PG8_MMA(0, 1, At, B1); PG8_BAR;
            PG8_LDA(At, 0, 1); PG8_STAGE(PG8_SA(0, 0), a2, voffA);
            PG8_BAR; PG8_WAIT_L(0); PG8_MMA(1, 0, At, B0); PG8_BAR; PG8_SCHED;
            PG8_STAGE(PG8_SB(0, 1), b2 + hstep, voffB);
            PG8_WAIT_V(6); PG8_BAR; PG8_MMA(1, 1, At, B1); PG8_BAR;
            PG8_LDB(B0, 1, 0); PG8_SCHED; PG8_LDA(At, 1, 0); PG8_STAGE(PG8_SA(0, 1), a2 + hstep, voffA);
            PG8_WAIT_L(8); PG8_BAR; PG8_WAIT_L(0); PG8_MMA(0, 0, At, B0); PG8_BAR; PG8_SCHED;
            PG8_LDB(B1, 1, 1); PG8_STAGE(PG8_SB(1, 0), b3, voffB);
            PG8_BAR; PG8_WAIT_L(0); PG8_MMA(0, 1, At, B1); PG8_BAR;
            PG8_LDA(At, 1, 1); PG8_STAGE(PG8_SA(1, 0), a3, voffA);
            PG8_BAR; PG8_WAIT_L(0); PG8_MMA(1, 0, At, B0); PG8_BAR; PG8_SCHED;
            PG8_STAGE(PG8_SB(1, 1), b3 + hstep, voffB);
            PG8_WAIT_V(6); PG8_BAR; PG8_MMA(1, 1, At, B1); PG8_BAR;
            }
        }
        if constexpr (ALIGN_EPI) { if (wr == 0) PG8_BAR; }
        if constexpr (!Epi::AFTER_DRAIN) { E(acc, cur, wr, wc, fr, fq); S.done(cur); }
        if (!has_next) break;
#pragma unroll
        for (int a = 0; a < 2; ++a)
#pragma unroll
            for (int b = 0; b < 2; ++b)
#pragma unroll
                for (int m = 0; m < 4; ++m)
#pragma unroll
                    for (int n = 0; n < 2; ++n) acc[a][b][m][n] = (f32x4){0.f, 0.f, 0.f, 0.f};
        cur = nxt; cA = nA; cB = nB; ++ui;
        if constexpr (ALIGN_EPI) { if (wr == 1) PG8_BAR; }
    }
    PG8_WAIT_V(0);
    if constexpr (!ALIGN_EPI) { if (wr == 0) PG8_BAR; }
    PG8_BAR;
    if constexpr (Epi::AFTER_DRAIN) { E.fused(acc, cur, wr, wc, fr, fq, lds, wid, lane); S.done(cur); }
#undef PG8_SA
#undef PG8_SB
#undef PG8_STAGE
#undef PG8_LDA
#undef PG8_LDB
#undef PG8_MMA
#undef PG8_WAIT_V
#undef PG8_WAIT_L
#undef PG8_BAR
#undef PG8_SCHED
}
}

#define LAS __attribute__((address_space(3)))
typedef unsigned short bf16_t;
typedef short bf16x8 __attribute__((ext_vector_type(8)));
typedef float f32x4 __attribute__((ext_vector_type(4)));
typedef float f32x2 __attribute__((ext_vector_type(2)));
typedef unsigned u32x4 __attribute__((ext_vector_type(4)));
typedef unsigned u32x2 __attribute__((ext_vector_type(2)));

constexpr int SEQ = 16384, DM = 2048, INW = 5392, NH = 5632;
constexpr int CQA = 0, CKA = 1024, CVA = 1152, CZA = 1280, CQG = 2304, CKG = 2816, CVG = 3328, CZG = 4352, CLR = 5376;
constexpr int GC = 128, NCH = SEQ / GC;
constexpr int NTHREADS = 512, NWAVES = 8;
constexpr int LDS_BYTES = 147456;
constexpr float LN_EPS = 1e-5f, RMS_EPS = 1e-5f;
constexpr size_t MiB = 1u << 20;
constexpr size_t WS_XB = 0;
constexpr size_t WS_WIN = 64 * MiB;
constexpr size_t WS_WOUT = 88 * MiB;
constexpr size_t WS_ROPE = 96 * MiB;
constexpr size_t WS_TOT = 100 * MiB;
constexpr size_t WS_H = 104 * MiB;
constexpr size_t WS_Y = 280 * MiB;
constexpr size_t WS_KV = 344 * MiB;
constexpr size_t WS_SC = 408 * MiB;
constexpr size_t WS_CTL = 440 * MiB, CTL_BYTES = 16384;
constexpr size_t WS_END = 441 * MiB;
constexpr int MISC_OFF = LDS_BYTES - 64;

__constant__ float INVF[32] = {1.000000000e+00f,7.498942018e-01f,5.623413324e-01f,4.216965139e-01f,3.162277639e-01f,2.371373922e-01f,1.778279394e-01f,1.333521456e-01f,1.000000015e-01f,7.498941571e-02f,5.623412877e-02f,4.216964915e-02f,3.162277862e-02f,2.371373586e-02f,1.778279431e-02f,1.333521493e-02f,9.999999776e-03f,7.498942316e-03f,5.623413250e-03f,4.216964822e-03f,3.162277862e-03f,2.371373819e-03f,1.778279431e-03f,1.333521446e-03f,1.000000047e-03f,7.498941850e-04f,5.623413017e-04f,4.216965463e-04f,3.162277862e-04f,2.371373848e-04f,1.778279402e-04f,1.333521504e-04f};

struct Params {
    const float* x; const float* w_in; const float* w_gk_up; const float* b_gk; const float* sinks; const float* gla_norm_w; const float* w_out; const float* ln_g; const float* ln_b;
    float* out; unsigned char* ws;
};

typedef __bf16 bf16x2_t __attribute__((ext_vector_type(2)));
__device__ __forceinline__ unsigned pk_bf16(float lo, float hi) { const f32x2 v = {lo, hi}; return __builtin_bit_cast(unsigned, __builtin_convertvector(v, bf16x2_t)); }
__device__ __forceinline__ float bflo(unsigned w) { return __uint_as_float(w << 16); }
__device__ __forceinline__ float bfhi(unsigned w) { return __uint_as_float(w & 0xffff0000u); }
__device__ __forceinline__ float bf2f(bf16_t v) { return __uint_as_float((unsigned)v << 16); }
__device__ __forceinline__ float silu(float z) { return z * __builtin_amdgcn_rcpf(1.f + __builtin_amdgcn_exp2f(z * -1.4426950408889634f)); }
__device__ __forceinline__ f32x4 mfma16(bf16x8 a, bf16x8 b, f32x4 c) { return __builtin_amdgcn_mfma_f32_16x16x32_bf16(a, b, c, 0, 0, 0); }
#define LDS_WAIT() asm volatile("s_waitcnt lgkmcnt(0)" ::: "memory")


#define RLX_AGENT __ATOMIC_RELAXED, __HIP_MEMORY_SCOPE_AGENT
#define XB_TMO      128
#define XB_XCNT(j)  (256  + 64 * (j))
#define XB_XSUB(j)  (1280 + 64 * (j))
#define XB_XGEN(j)  (2304 + 64 * (j))
#define XB_TOP      3328
#define XB_TOPGEN   3392
#define XCD_BAR_WORDS 3456
#define XB_SPIN_CAP (1u << 18)

__device__ __forceinline__ unsigned xb_ld(unsigned* p)              { return __hip_atomic_load(p, __ATOMIC_RELAXED, __HIP_MEMORY_SCOPE_AGENT); }
__device__ __forceinline__ unsigned xb_add(unsigned* p, unsigned v) { return __hip_atomic_fetch_add(p, v, __ATOMIC_RELAXED, __HIP_MEMORY_SCOPE_AGENT); }
__device__ __forceinline__ unsigned xb_xcc_id() { return (unsigned)__builtin_amdgcn_s_getreg((3 << 11) | 20) & 0xFu; }
#define XB_SPIN(cond, bar) do { unsigned _sp = 0; while (cond) { __builtin_amdgcn_s_sleep(1); \
    if ((++_sp & 255u) == 0u) { if (xb_ld(&(bar)[XB_TMO])) break; if (_sp > XB_SPIN_CAP) { atomicAdd(&(bar)[XB_TMO], 1u); break; } } } } while (0)

struct XcdBarrier {
    unsigned* bar; unsigned x;
    volatile LAS unsigned* st;
};

__device__ __forceinline__ XcdBarrier xcd_barrier_post(unsigned* bar, volatile LAS unsigned* st) {
    XcdBarrier b; b.bar = bar; b.x = xb_xcc_id(); b.st = st;
    if (threadIdx.x == 0) (void)xb_add(&bar[XB_XCNT(b.x)], 1u);
    return b;
}
__device__ __forceinline__ void xcd_barrier_complete(unsigned* bar, unsigned x, unsigned& nloc, unsigned& nx) {
    const unsigned G = gridDim.x * gridDim.y * gridDim.z;
    unsigned sum, cnt, mine, sp = 0u;
    for (;;) {
        sum = 0u; cnt = 0u; mine = 0u;
#pragma unroll
        for (unsigned j = 0; j < 16; ++j) { const unsigned c = xb_ld(&bar[XB_XCNT(j)]); sum += c; cnt += (c > 0u) ? 1u : 0u; mine = (j == x) ? c : mine; }
        if (sum == G) break;
        __builtin_amdgcn_s_sleep(1);
        if ((++sp & 255u) == 0u) { if (xb_ld(&bar[XB_TMO])) break; if (sp > XB_SPIN_CAP) { atomicAdd(&bar[XB_TMO], 1u); break; } }
    }
    nloc = mine > 0u ? mine : 1u; nx = cnt > 0u ? cnt : 1u;
}

__device__ __forceinline__ void xcd_barrier(const XcdBarrier& b) {
    asm volatile("s_waitcnt vmcnt(0)" ::: "memory");
    __syncthreads();
    if (threadIdx.x == 0) {
        unsigned* bar = b.bar;
        __builtin_amdgcn_s_waitcnt(0);
        unsigned nloc = b.st[0], nx = b.st[1];
        if (nloc == 0u) { xcd_barrier_complete(bar, b.x, nloc, nx); b.st[0] = nloc; b.st[1] = nx; }
        const unsigned old = xb_add(&bar[XB_XSUB(b.x)], 1u);
        const unsigned gen = old / nloc;
        if (old + 1u == (gen + 1u) * nloc) {
            __builtin_amdgcn_fence(__ATOMIC_RELEASE, "agent");
            asm volatile("s_waitcnt vmcnt(0)" ::: "memory");
            const unsigned og = xb_add(&bar[XB_TOP], 1u);
            const unsigned tg = og / nx;
            if (og + 1u == (tg + 1u) * nx) xb_add(&bar[XB_TOPGEN], 1u);
            else XB_SPIN(xb_ld(&bar[XB_TOPGEN]) == tg, bar);
            __builtin_amdgcn_fence(__ATOMIC_ACQUIRE, "agent");
            xb_add(&bar[XB_XGEN(b.x)], 1u);
            asm volatile("s_waitcnt vmcnt(0)" ::: "memory");
        } else {
            XB_SPIN(xb_ld(&bar[XB_XGEN(b.x)]) == gen, bar);
            __builtin_amdgcn_fence(__ATOMIC_ACQUIRE, "agent");
            asm volatile("s_waitcnt vmcnt(0)" ::: "memory");
        }
    }
    __syncthreads();
}

__device__ __forceinline__ void p0_transpose_item(const float* W, int K, int N, int NP, bf16_t* WT, LAS float* scr, int item, int lane) {
    const int nblk = NP / 32, kb = item / nblk, nb = item % nblk, k0 = 64 * kb, n0 = 32 * nb;
    const int ncol = n0 + (lane & 31);
#pragma unroll
    for (int i = 0; i < 32; ++i) { const int kk = 2 * i + (lane >> 5); scr[kk * 33 + (lane & 31)] = (ncol < N) ? __builtin_nontemporal_load(W + (size_t)(k0 + kk) * N + ncol) : 0.f; }
    LDS_WAIT(); asm volatile("" ::: "memory");
    const int c = lane & 7;
#pragma unroll
    for (int j = 0; j < 4; ++j) { const int n = (lane >> 3) + 8 * j; const LAS float* s = scr + (8 * c) * 33 + n;
        u32x4 o; o.x = pk_bf16(s[0 * 33], s[1 * 33]); o.y = pk_bf16(s[2 * 33], s[3 * 33]); o.z = pk_bf16(s[4 * 33], s[5 * 33]); o.w = pk_bf16(s[6 * 33], s[7 * 33]);
        *(u32x4*)(WT + (size_t)(n0 + n) * K + k0 + 8 * c) = o; }
    LDS_WAIT(); asm volatile("" ::: "memory");
}

__device__ __forceinline__ void phase_prologue(const Params& p, LAS unsigned char* lds, int tid, int wid, int lane) {
    unsigned char* ws = p.ws;
    const int G = gridDim.x;
    {
        const f32x4* x4 = (const f32x4*)p.x; u32x4* xb = (u32x4*)(ws + WS_XB);
        const size_t n8 = (size_t)SEQ * DM / 8, stride = (size_t)G * NTHREADS;
        for (size_t i = (size_t)blockIdx.x * NTHREADS + tid; i < n8; i += 4 * stride) {
            f32x4 a[4], b[4];
#pragma unroll
            for (int u = 0; u < 4; ++u) { const size_t idx = i + u * stride; if (idx < n8) { a[u] = __builtin_nontemporal_load(x4 + 2 * idx); b[u] = __builtin_nontemporal_load(x4 + 2 * idx + 1); } }
#pragma unroll
            for (int u = 0; u < 4; ++u) { const size_t idx = i + u * stride; if (idx < n8) {
                u32x4 w; w.x = pk_bf16(a[u].x, a[u].y); w.y = pk_bf16(a[u].z, a[u].w); w.z = pk_bf16(b[u].x, b[u].y); w.w = pk_bf16(b[u].z, b[u].w);
                xb[idx] = w; } }
        }
    }
    {
        LAS float* scr = (LAS float*)(lds + wid * 8448);
        const int gw = blockIdx.x * NWAVES + wid, NGW = G * NWAVES;
        constexpr int I_IN = (DM / 64) * (NH / 32), I_OUT = (DM / 64) * (DM / 32);
        for (int it = gw; it < I_IN + I_OUT; it += NGW) {
            if (it < I_IN) p0_transpose_item(p.w_in, DM, INW, NH, (bf16_t*)(ws + WS_WIN), scr, it, lane);
            else p0_transpose_item(p.w_out, DM, DM, DM, (bf16_t*)(ws + WS_WOUT), scr, it - I_IN, lane);
        }
    }
    {
        float* rope = (float*)(ws + WS_ROPE);
        const int n = SEQ * 32, stride = G * NTHREADS;
        for (int i = blockIdx.x * NTHREADS + tid; i < n; i += stride) {
            const int pos = i >> 5, j = i & 31;
            const float ang = (float)pos * INVF[j];
            const double a = (double)ang;
            const double kq = __builtin_rint(a * 0.63661977236758134308);
            const double y = a - kq * 1.57079632679489661923;
            const double y2 = y * y;
            double sp = -1.0 / 6227020800.0; sp = sp * y2 + 1.0 / 39916800.0; sp = sp * y2 - 1.0 / 362880.0; sp = sp * y2 + 1.0 / 5040.0; sp = sp * y2 - 1.0 / 120.0; sp = sp * y2 + 1.0 / 6.0;
            const double sn = y - y * y2 * sp;
            double cp = 1.0 / 87178291200.0; cp = cp * y2 - 1.0 / 479001600.0; cp = cp * y2 + 1.0 / 3628800.0; cp = cp * y2 - 1.0 / 40320.0; cp = cp * y2 + 1.0 / 720.0; cp = cp * y2 - 1.0 / 24.0; cp = cp * y2 + 0.5;
            const double cs = 1.0 - y2 * cp;
            const int q = ((int)kq) & 3;
            const double s_o = (q == 0) ? sn : (q == 1) ? cs : (q == 2) ? -sn : -cs;
            const double c_o = (q == 0) ? cs : (q == 1) ? -sn : (q == 2) ? -cs : sn;
            rope[(size_t)pos * 64 + j] = (float)c_o; rope[(size_t)pos * 64 + 32 + j] = (float)s_o;
        }
    }
}

typedef short s16x4 __attribute__((ext_vector_type(4)));
constexpr int A_KLD = 72, A_VLD = 72;
__device__ __forceinline__ void rope8v(const u32x4 a, const u32x4 b, const f32x4 c0, const f32x4 c1, const f32x4 s0, const f32x4 s1, float scale, u32x4& lo, u32x4& hi) {
    const unsigned aw[4] = {a.x, a.y, a.z, a.w}, bw[4] = {b.x, b.y, b.z, b.w};
    const float cs[8] = {c0.x, c0.y, c0.z, c0.w, c1.x, c1.y, c1.z, c1.w}, sn[8] = {s0.x, s0.y, s0.z, s0.w, s1.x, s1.y, s1.z, s1.w};
    unsigned lw[4], hw[4];
#pragma unroll
    for (int i = 0; i < 4; ++i) {
        const float x1a = bflo(aw[i]), x1b = bfhi(aw[i]), x2a = bflo(bw[i]), x2b = bfhi(bw[i]);
        const float o1a = (x1a * cs[2 * i] - x2a * sn[2 * i]) * scale, o1b = (x1b * cs[2 * i + 1] - x2b * sn[2 * i + 1]) * scale;
        const float o2a = (x2a * cs[2 * i] + x1a * sn[2 * i]) * scale, o2b = (x2b * cs[2 * i + 1] + x1b * sn[2 * i + 1]) * scale;
        lw[i] = pk_bf16(o1a, o1b); hw[i] = pk_bf16(o2a, o2b);
    }
    lo = (u32x4){lw[0], lw[1], lw[2], lw[3]}; hi = (u32x4){hw[0], hw[1], hw[2], hw[3]};
}
struct QPre { u32x4 a, b; f32x4 c0, c1, s0, s1; u32x4 z0, z1; };
__device__ __forceinline__ QPre attn_qload(const bf16_t* H, const float* ROPE, int pos, int hq, int fq) {
    QPre q;
    const bf16_t* qp = H + (size_t)pos * NH + CQA + hq * 64 + 8 * fq;
    q.a = *(const u32x4*)qp; q.b = *(const u32x4*)(qp + 32);
    const float* rp = ROPE + (size_t)pos * 64 + 8 * fq;
    q.c0 = *(const f32x4*)rp; q.c1 = *(const f32x4*)(rp + 4); q.s0 = *(const f32x4*)(rp + 32); q.s1 = *(const f32x4*)(rp + 36);
    const bf16_t* zp = H + (size_t)pos * NH + CZA + hq * 64 + 8 * fq;
    q.z0 = *(const u32x4*)zp; q.z1 = *(const u32x4*)(zp + 32);
    return q;
}

__device__ __forceinline__ void attn_unit(const Params& p, LAS unsigned char* lds, int nb, int kvh, int tid, int wid, int lane) {
    const bf16_t* H = (const bf16_t*)(p.ws + WS_H); const float* ROPE = (const float*)(p.ws + WS_ROPE); bf16_t* Y = (bf16_t*)(p.ws + WS_Y);
    LAS bf16_t* KL = (LAS bf16_t*)lds; LAS bf16_t* VT = KL + 256 * A_KLD;
    const int fr = lane & 15, fq = lane >> 4;
    const int hq = kvh * 8 + wid;
    u32x4 ka[2], kb[2], vv[4]; f32x4 kc0[2], kc1[2], ks0[2], ks1[2];
#pragma unroll
    for (int j = 0; j < 2; ++j) {
        const int task = tid + NTHREADS * j; const int key = task >> 2, g = task & 3; const int pos = (nb - 1) * 128 + key;
        ka[j] = (u32x4){0u, 0u, 0u, 0u}; kb[j] = ka[j]; kc0[j] = (f32x4){0.f, 0.f, 0.f, 0.f}; kc1[j] = kc0[j]; ks0[j] = kc0[j]; ks1[j] = kc0[j];
        if (pos >= 0) {
            const bf16_t* kp = H + (size_t)pos * NH + CKA + kvh * 64 + 8 * g;
            ka[j] = *(const u32x4*)kp; kb[j] = *(const u32x4*)(kp + 32);
            const float* rp = ROPE + (size_t)pos * 64 + 8 * g;
            kc0[j] = *(const f32x4*)rp; kc1[j] = *(const f32x4*)(rp + 4); ks0[j] = *(const f32x4*)(rp + 32); ks1[j] = *(const f32x4*)(rp + 36);
        }
    }
#pragma unroll
    for (int j = 0; j < 4; ++j) {
        const int task = tid + NTHREADS * j; const int key = task >> 3, dg = task & 7; const int pos = (nb - 1) * 128 + key;
        vv[j] = (u32x4){0u, 0u, 0u, 0u};
        if (pos >= 0) vv[j] = *(const u32x4*)(H + (size_t)pos * NH + CVA + kvh * 64 + 8 * dg);
    }
    const float sink = p.sinks[hq] * 1.4426950408889634f;
    QPre nxt = attn_qload(H, ROPE, nb * 128 + fr, hq, fq);
    __syncthreads();
#pragma unroll
    for (int j = 0; j < 2; ++j) {
        const int task = tid + NTHREADS * j; const int key = task >> 2, g = task & 3;
        u32x4 lo, hi; rope8v(ka[j], kb[j], kc0[j], kc1[j], ks0[j], ks1[j], 1.0f, lo, hi);
        *(LAS u32x4*)(KL + key * A_KLD + 8 * g) = lo; *(LAS u32x4*)(KL + key * A_KLD + 32 + 8 * g) = hi;
    }
#pragma unroll
    for (int j = 0; j < 4; ++j) {
        const int task = tid + NTHREADS * j; const int key = task >> 3, dg = task & 7;
        *(LAS u32x4*)(VT + key * A_VLD + 8 * dg) = vv[j];
    }
    __syncthreads();
#pragma unroll 1
    for (int it = 0; it < 8; ++it) {
        const int pos = nb * 128 + 16 * it + fr;
        const QPre cur = nxt;
        if (it < 7) nxt = attn_qload(H, ROPE, pos + 16, hq, fq);
        bf16x8 qlo, qhi;
        { u32x4 lo, hi; rope8v(cur.a, cur.b, cur.c0, cur.c1, cur.s0, cur.s1, 0.125f * 1.4426950408889634f, lo, hi); qlo = __builtin_bit_cast(bf16x8, lo); qhi = __builtin_bit_cast(bf16x8, hi); }
        f32x4 s[9];
#pragma unroll
        for (int j = 0; j < 9; ++j) {
            const LAS bf16_t* kp = KL + (16 * (it + j) + fr) * A_KLD + 8 * fq;
            const bf16x8 k0 = *(const LAS bf16x8*)kp, k1 = *(const LAS bf16x8*)(kp + 32);
            f32x4 acc = (f32x4){0.f, 0.f, 0.f, 0.f};
            acc = mfma16(k0, qlo, acc); acc = mfma16(k1, qhi, acc);
            s[j] = acc;
        }
#pragma unroll
        for (int r = 0; r < 4; ++r) { s[0][r] = (fr >= 4 * fq + r) ? -INFINITY : s[0][r]; s[8][r] = (4 * fq + r > fr) ? -INFINITY : s[8][r]; }
        if (nb == 0) {
#pragma unroll
            for (int j = 0; j < 8; ++j) if (it + j < 8) s[j] = (f32x4){-INFINITY, -INFINITY, -INFINITY, -INFINITY};
        }
        float m = sink;
#pragma unroll
        for (int j = 0; j < 9; ++j) m = fmaxf(fmaxf(m, fmaxf(s[j][0], s[j][1])), fmaxf(s[j][2], s[j][3]));
        m = fmaxf(m, __shfl_xor(m, 16)); m = fmaxf(m, __shfl_xor(m, 32));
        float l = 0.f;
#pragma unroll
        for (int j = 0; j < 9; ++j)
#pragma unroll
            for (int r = 0; r < 4; ++r) { const float e = __builtin_amdgcn_exp2f(s[j][r] - m); s[j][r] = e; l += e; }
        l += __shfl_xor(l, 16); l += __shfl_xor(l, 32);
        l += __builtin_amdgcn_exp2f(sink - m);
        const float inv = __builtin_amdgcn_rcpf(l);
        f32x4 o[4];
#pragma unroll
        for (int dt = 0; dt < 4; ++dt) o[dt] = (f32x4){0.f, 0.f, 0.f, 0.f};
#pragma unroll
        for (int pp = 0; pp < 5; ++pp) {
            const int j0 = 2 * pp, j1 = (pp < 4) ? 2 * pp + 1 : 2 * pp;
            u32x4 pw; pw.x = pk_bf16(s[j0][0], s[j0][1]); pw.y = pk_bf16(s[j0][2], s[j0][3]);
            if (pp < 4) { pw.z = pk_bf16(s[j1][0], s[j1][1]); pw.w = pk_bf16(s[j1][2], s[j1][3]); } else { pw.z = 0u; pw.w = 0u; }
            const bf16x8 pf = __builtin_bit_cast(bf16x8, pw);
#pragma unroll
            for (int dt = 0; dt < 4; ++dt) {
                const LAS bf16_t* vp = VT + (4 * fq + (fr >> 2)) * A_VLD + 32 * (dt >> 1) + 8 * (fr & 3) + 4 * (dt & 1);
                const s16x4 v0 = __builtin_amdgcn_ds_read_tr16_b64_v4i16((LAS s16x4*)(vp + 16 * (it + j0) * A_VLD)), v1 = __builtin_amdgcn_ds_read_tr16_b64_v4i16((LAS s16x4*)(vp + 16 * (it + j1) * A_VLD));
                o[dt] = mfma16((bf16x8){v0[0], v0[1], v0[2], v0[3], v1[0], v1[1], v1[2], v1[3]}, pf, o[dt]);
            }
        }
#pragma unroll
        for (int hh = 0; hh < 2; ++hh) {
            const int d0 = 32 * hh + 8 * fq; const u32x4 zw = hh ? cur.z1 : cur.z0; const f32x4 oa = o[2 * hh], ob = o[2 * hh + 1];
            u32x4 w;
            w.x = pk_bf16(oa[0] * inv * silu(bflo(zw.x)), oa[1] * inv * silu(bfhi(zw.x))); w.y = pk_bf16(oa[2] * inv * silu(bflo(zw.y)), oa[3] * inv * silu(bfhi(zw.y)));
            w.z = pk_bf16(ob[0] * inv * silu(bflo(zw.z)), ob[1] * inv * silu(bfhi(zw.z))); w.w = pk_bf16(ob[2] * inv * silu(bflo(zw.w)), ob[3] * inv * silu(bfhi(zw.w)));
            *(u32x4*)(Y + (size_t)pos * DM + hq * 64 + d0) = w;
        }
    }
}

constexpr int G_LD = 136;
constexpr int GL_Q = 0, GL_K = 34816, GL_V = 69632, GL_G = 139264, GL_P = 143360;
static_assert(GL_P + 2048 <= MISC_OFF, "GLA LDS map");
struct GlaLoads { u32x2 gkw; u32x4 kw[4]; u32x4 vw[8]; float wub[4]; float bias; };
__device__ __forceinline__ void gla_issue(const Params& p, const bf16_t* H, int t0, int h, int tid, GlaLoads& L) {
    L.gkw = *(const u32x2*)(H + (size_t)(t0 + (tid >> 2)) * NH + CLR + 4 * (tid & 3));
#pragma unroll
    for (int j = 0; j < 4; ++j) { const int idx = tid + NTHREADS * j, tok = idx >> 4, dg = idx & 15; L.kw[j] = *(const u32x4*)(H + (size_t)(t0 + tok) * NH + CKG + h * 128 + 8 * dg); }
#pragma unroll
    for (int j = 0; j < 8; ++j) { const int idx = tid + NTHREADS * j, tok = idx >> 5, dvg = idx & 31; L.vw[j] = *(const u32x4*)(H + (size_t)(t0 + tok) * NH + CVG + h * 256 + 8 * dvg); }
    const int dch = h * 128 + 16 * (tid >> 6) + (tid & 15), fqq = (tid >> 4) & 3;
#pragma unroll
    for (int s = 0; s < 4; ++s) L.wub[s] = p.w_gk_up[(4 * s + fqq) * 512 + dch];
    L.bias = p.b_gk[dch];
}
__device__ __forceinline__ void gla_store_gk(LAS bf16_t* GLb, const GlaLoads& L, int tid) {
    LAS bf16_t* g = GLb + (tid >> 2) * 16 + (tid & 3);
    g[0] = (bf16_t)(L.gkw.x & 0xffffu); g[4] = (bf16_t)(L.gkw.x >> 16); g[8] = (bf16_t)(L.gkw.y & 0xffffu); g[12] = (bf16_t)(L.gkw.y >> 16);
}
constexpr int V_LD = 272;
__device__ __forceinline__ void gla_store_vt(LAS bf16_t* VN, const GlaLoads& L, int tid) {
#pragma unroll
    for (int j = 0; j < 8; ++j) { const int idx = tid + NTHREADS * j, tok = idx >> 5, dvg = idx & 31; *(LAS u32x4*)(VN + tok * V_LD + 8 * dvg) = L.vw[j]; }
}
__device__ __forceinline__ bf16x8 v_frag_tr(const LAS bf16_t* VN, int c, int ks, int lane) {
    const int g = lane >> 4, q = (lane & 15) >> 2, pp = lane & 3;
    const LAS bf16_t* p0 = VN + (32 * ks + 8 * g + q) * V_LD + 16 * c + 4 * pp;
    const s16x4 a = __builtin_amdgcn_ds_read_tr16_b64_v4i16((LAS s16x4*)p0), b = __builtin_amdgcn_ds_read_tr16_b64_v4i16((LAS s16x4*)(p0 + 4 * V_LD));
    return (bf16x8){a[0], a[1], a[2], a[3], b[0], b[1], b[2], b[3]};
}
__device__ __forceinline__ bf16x8 v_frag_tr8(const LAS bf16_t* VN, int cb, int ks, int lane) {
    const int g = lane >> 4, q = (lane & 15) >> 2, pp = lane & 3;
    const LAS bf16_t* p0 = VN + (32 * ks + 8 * g + q) * V_LD + cb + 8 * pp;
    const s16x4 a = __builtin_amdgcn_ds_read_tr16_b64_v4i16((LAS s16x4*)p0), b = __builtin_amdgcn_ds_read_tr16_b64_v4i16((LAS s16x4*)(p0 + 4 * V_LD));
    return (bf16x8){a[0], a[1], a[2], a[3], b[0], b[1], b[2], b[3]};
}
__device__ __forceinline__ void gla_decay(const GlaLoads& L, const LAS bf16_t* GLb, int fr, int fq, float (&bc)[8][4], float& btot) {
    float carry = 0.f;
#pragma unroll
    for (int T = 0; T < 8; ++T) {
        const u32x2 gw = *(const LAS u32x2*)(GLb + (16 * T + fr) * 16 + 4 * fq);
        f32x4 acc = (f32x4){L.bias, L.bias, L.bias, L.bias};
        acc = __builtin_amdgcn_mfma_f32_16x16x4f32(bflo(gw.x), L.wub[0], acc, 0, 0, 0);
        acc = __builtin_amdgcn_mfma_f32_16x16x4f32(bfhi(gw.x), L.wub[1], acc, 0, 0, 0);
        acc = __builtin_amdgcn_mfma_f32_16x16x4f32(bflo(gw.y), L.wub[2], acc, 0, 0, 0);
        acc = __builtin_amdgcn_mfma_f32_16x16x4f32(bfhi(gw.y), L.wub[3], acc, 0, 0, 0);
        float cs[4]; float run = 0.f;
#pragma unroll
        for (int r = 0; r < 4; ++r) { const float z2 = acc[r] * 1.4426950408889634f; const float ls2 = fminf(z2, 0.f) - __builtin_amdgcn_logf(1.f + __builtin_amdgcn_exp2f(-fabsf(z2))); run += ls2 * (1.f / 16.f); cs[r] = run; }
        const float t0 = __shfl(run, fr), t1 = __shfl(run, fr + 16), t2 = __shfl(run, fr + 32), t3 = __shfl(run, fr + 48);
        const float base = carry + (fq > 0 ? t0 : 0.f) + (fq > 1 ? t1 : 0.f) + (fq > 2 ? t2 : 0.f);
#pragma unroll
        for (int r = 0; r < 4; ++r) bc[T][r] = base + cs[r];
        carry += (t0 + t1) + (t2 + t3);
    }
    btot = carry;
}

__device__ __forceinline__ void gla_kv_unit(const Params& p, LAS unsigned char* lds, int c, int h, int tid, int wid, int lane) {
    const bf16_t* H = (const bf16_t*)(p.ws + WS_H);
    LAS bf16_t* KN = (LAS bf16_t*)(lds + GL_Q);
    LAS bf16_t* KT = (LAS bf16_t*)(lds + GL_K);
    LAS bf16_t* VT = (LAS bf16_t*)(lds + GL_V);
    LAS bf16_t* GLb = (LAS bf16_t*)(lds + GL_G);
    const int t0 = c * GC, fr = lane & 15, fq = lane >> 4, d = 16 * wid + fr;
    GlaLoads L; gla_issue(p, H, t0, h, tid, L);
    __syncthreads();
    gla_store_gk(GLb, L, tid);
#pragma unroll
    for (int j = 0; j < 4; ++j) { const int idx = tid + NTHREADS * j, tok = idx >> 4, dg = idx & 15; *(LAS u32x4*)(KN + tok * G_LD + 8 * dg) = L.kw[j]; }
    gla_store_vt(VT, L, tid);
    __syncthreads();
    {
        float bc[8][4], btot;
        gla_decay(L, GLb, fr, fq, bc, btot);
#pragma unroll
        for (int T = 0; T < 8; ++T) {
            const s16x4 kv4 = __builtin_amdgcn_ds_read_tr16_b64_v4i16((LAS s16x4*)(KN + (16 * T + 4 * fq + (fr >> 2)) * G_LD + 16 * wid + 4 * (fr & 3)));
            float kt[4];
#pragma unroll
            for (int r = 0; r < 4; ++r) kt[r] = bf2f((bf16_t)kv4[r]) * __builtin_amdgcn_exp2f(-bc[T][r]);
            u32x2 w; w.x = pk_bf16(kt[0], kt[1]); w.y = pk_bf16(kt[2], kt[3]);
            *(LAS u32x2*)(KT + d * G_LD + 16 * T + 4 * fq) = w;
        }
        if (fq == 0) ((float*)(p.ws + WS_TOT))[(c * 4 + h) * 128 + d] = __builtin_amdgcn_exp2f(btot);
    }
    __syncthreads();
    bf16_t* KV = (bf16_t*)(p.ws + WS_KV) + (size_t)(c * 4 + h) * 32768;
#pragma unroll
    for (int jv = 0; jv < 2; ++jv) {
        const int dv0 = 32 * wid + 16 * jv;
        bf16x8 vf[4];
#pragma unroll
        for (int ks = 0; ks < 4; ++ks) vf[ks] = v_frag_tr(VT, 2 * wid + jv, ks, lane);
#pragma unroll
        for (int m = 0; m < 4; ++m) {
            f32x4 acc0 = (f32x4){0.f, 0.f, 0.f, 0.f}, acc1 = acc0;
#pragma unroll
            for (int ks = 0; ks < 4; ++ks) {
                const LAS bf16_t* kp = KT + (32 * m + 8 * (fr >> 2) + (fr & 3)) * G_LD + 32 * ks + 8 * fq;
                acc0 = mfma16(*(const LAS bf16x8*)kp, vf[ks], acc0); acc1 = mfma16(*(const LAS bf16x8*)(kp + 4 * G_LD), vf[ks], acc1);
            }
            u32x4 w; w.x = pk_bf16(acc0[0], acc0[1]); w.y = pk_bf16(acc0[2], acc0[3]); w.z = pk_bf16(acc1[0], acc1[1]); w.w = pk_bf16(acc1[2], acc1[3]);
            *(u32x4*)(KV + (size_t)(dv0 + fr) * 128 + 32 * m + 8 * fq) = w;
        }
    }
}

__device__ __forceinline__ void phase_scan(const Params& p, int tid) {
    const bf16_t* KV = (const bf16_t*)(p.ws + WS_KV); const float* TOT = (const float*)(p.ws + WS_TOT); bf16_t* SC = (bf16_t*)(p.ws + WS_SC);
    for (int e = blockIdx.x * NTHREADS + tid; e < 131072; e += gridDim.x * NTHREADS) {
        const int h = e >> 15, dk = e & 127;
        float s = 0.f;
        for (int c0 = 0; c0 < NCH; c0 += 16) {
            float kv[16], tt[16];
#pragma unroll
            for (int j = 0; j < 16; ++j) { kv[j] = bf2f(KV[(size_t)(c0 + j) * 131072 + e]); tt[j] = TOT[(c0 + j) * 512 + h * 128 + dk]; }
#pragma unroll
            for (int j = 0; j < 16; ++j) { SC[(size_t)(c0 + j) * 131072 + e] = (bf16_t)(pk_bf16(s, 0.f) & 0xffffu); s = tt[j] * (s + kv[j]); }
        }
    }
}

__device__ __forceinline__ void gla_out_unit(const Params& p, LAS unsigned char* lds, int c, int h, int tid, int wid, int lane) {
    const bf16_t* H = (const bf16_t*)(p.ws + WS_H); bf16_t* Y = (bf16_t*)(p.ws + WS_Y);
    LAS bf16_t* QL = (LAS bf16_t*)(lds + GL_Q);
    LAS bf16_t* KL = (LAS bf16_t*)(lds + GL_K);
    LAS bf16_t* VT = (LAS bf16_t*)(lds + GL_V);
    LAS bf16_t* GLb = (LAS bf16_t*)(lds + GL_G); LAS float* RS = (LAS float*)(lds + GL_G);
    const int t0 = c * GC, fr = lane & 15, fq = lane >> 4, d = 16 * wid + fr;
    GlaLoads L; gla_issue(p, H, t0, h, tid, L);
    u32x4 qw[4];
#pragma unroll
    for (int j = 0; j < 4; ++j) { const int idx = tid + NTHREADS * j, tok = idx >> 4, dg = idx & 15; qw[j] = *(const u32x4*)(H + (size_t)(t0 + tok) * NH + CQG + h * 128 + 8 * dg); }
    const bf16_t* SC = (const bf16_t*)(p.ws + WS_SC) + (size_t)(c * 4 + h) * 32768;
    bf16x8 sf[2][4];
#pragma unroll
    for (int jv = 0; jv < 2; ++jv)
#pragma unroll
        for (int ks = 0; ks < 4; ++ks) sf[jv][ks] = *(const bf16x8*)(SC + (size_t)(32 * wid + 8 * (fr >> 2) + 4 * jv + (fr & 3)) * 128 + 32 * ks + 8 * fq);
    __syncthreads();
    gla_store_gk(GLb, L, tid);
#pragma unroll
    for (int j = 0; j < 4; ++j) { const int idx = tid + NTHREADS * j, tok = idx >> 4, dg = idx & 15; *(LAS u32x4*)(QL + tok * G_LD + 8 * dg) = qw[j]; *(LAS u32x4*)(KL + tok * G_LD + 8 * dg) = L.kw[j]; }
    gla_store_vt(VT, L, tid);
    __syncthreads();
    {
        float bc[8][4], btot;
        gla_decay(L, GLb, fr, fq, bc, btot);
#pragma unroll
        for (int T = 0; T < 8; ++T) {
            const int ta = (16 * T + 4 * fq + (fr >> 2)) * G_LD + 16 * wid + 4 * (fr & 3);
            const s16x4 q4 = __builtin_amdgcn_ds_read_tr16_b64_v4i16((LAS s16x4*)(QL + ta)), k4 = __builtin_amdgcn_ds_read_tr16_b64_v4i16((LAS s16x4*)(KL + ta));
#pragma unroll
            for (int r = 0; r < 4; ++r) {
                const float e = __builtin_amdgcn_exp2f(bc[T][r]); const int o = (16 * T + 4 * fq + r) * G_LD + d;
                const float qv = bf2f((bf16_t)q4[r]) * 0.08838834764831845f * e;
                const float kv = bf2f((bf16_t)k4[r]) * __builtin_amdgcn_rcpf(e);
                QL[o] = (bf16_t)(pk_bf16(qv, 0.f) & 0xffffu);
                KL[o] = (bf16_t)(pk_bf16(kv, 0.f) & 0xffffu);
            }
        }
    }
    __syncthreads();
    f32x4 at[8];
    {
        bf16x8 qf[4];
#pragma unroll
        for (int ks = 0; ks < 4; ++ks) qf[ks] = *(const LAS bf16x8*)(QL + (16 * wid + fr) * G_LD + 32 * ks + 8 * fq);
#pragma unroll
        for (int jt = 0; jt < 8; ++jt) {
            f32x4 acc = (f32x4){0.f, 0.f, 0.f, 0.f};
            if (jt <= wid) {
#pragma unroll
                for (int ks = 0; ks < 4; ++ks) { const bf16x8 kf = *(const LAS bf16x8*)(KL + (16 * jt + fr) * G_LD + 32 * ks + 8 * fq); acc = mfma16(kf, qf[ks], acc); }
                if (jt == wid) {
#pragma unroll
                    for (int r = 0; r < 4; ++r) acc[r] = (4 * fq + r <= fr) ? acc[r] : 0.f;
                }
            }
            at[jt] = acc;
        }
    }
    __syncthreads();
#pragma unroll
    for (int jt = 0; jt < 8; ++jt) { u32x2 w; w.x = pk_bf16(at[jt][0], at[jt][1]); w.y = pk_bf16(at[jt][2], at[jt][3]); *(LAS u32x2*)(KL + (16 * wid + fr) * G_LD + 16 * jt + 4 * fq) = w; }
    __syncthreads();
    bf16x8 vf[2][4];
#pragma unroll
    for (int jv = 0; jv < 2; ++jv)
#pragma unroll
        for (int ks = 0; ks < 4; ++ks) vf[jv][ks] = v_frag_tr8(VT, 32 * wid + 4 * jv, ks, lane);
    f32x4 o[8][2];
#pragma unroll
    for (int i = 0; i < 8; ++i) {
        bf16x8 af[4], qf[4];
#pragma unroll
        for (int ks = 0; ks < 4; ++ks) { af[ks] = *(const LAS bf16x8*)(KL + (16 * i + fr) * G_LD + 32 * ks + 8 * fq); qf[ks] = *(const LAS bf16x8*)(QL + (16 * i + fr) * G_LD + 32 * ks + 8 * fq); }
        float ssp = 0.f;
#pragma unroll
        for (int jv = 0; jv < 2; ++jv) {
            f32x4 acc = (f32x4){0.f, 0.f, 0.f, 0.f};
#pragma unroll
            for (int ks = 0; ks < 4; ++ks) if (ks <= i / 2) acc = mfma16(vf[jv][ks], af[ks], acc);
#pragma unroll
            for (int ks = 0; ks < 4; ++ks) acc = mfma16(sf[jv][ks], qf[ks], acc);
            o[i][jv] = acc;
            ssp += (acc[0] * acc[0] + acc[1] * acc[1]) + (acc[2] * acc[2] + acc[3] * acc[3]);
        }
        ssp += __shfl_xor(ssp, 16); ssp += __shfl_xor(ssp, 32);
        if (fq == 0) RS[wid * 128 + 16 * i + fr] = ssp;
    }
    u32x4 zw[8];
#pragma unroll
    for (int i = 0; i < 8; ++i) zw[i] = *(const u32x4*)(H + (size_t)(t0 + 16 * i + fr) * NH + CZG + h * 256 + 32 * wid + 8 * fq);
    __syncthreads();
    const f32x4 nw0 = *(const f32x4*)(p.gla_norm_w + 32 * wid + 8 * fq), nw1 = *(const f32x4*)(p.gla_norm_w + 32 * wid + 8 * fq + 4);
#pragma unroll
    for (int i = 0; i < 8; ++i) {
        float tot = 0.f;
#pragma unroll
        for (int w = 0; w < 8; ++w) tot += RS[w * 128 + 16 * i + fr];
        const float rstd = __builtin_amdgcn_rsqf(tot * (1.f / 256.f) + RMS_EPS);
        const int tok = t0 + 16 * i + fr;
        const u32x4 z = zw[i]; const f32x4 a = o[i][0], b = o[i][1];
        u32x4 w;
        w.x = pk_bf16(a[0] * rstd * nw0.x * silu(bflo(z.x)), a[1] * rstd * nw0.y * silu(bfhi(z.x))); w.y = pk_bf16(a[2] * rstd * nw0.z * silu(bflo(z.y)), a[3] * rstd * nw0.w * silu(bfhi(z.y)));
        w.z = pk_bf16(b[0] * rstd * nw1.x * silu(bflo(z.z)), b[1] * rstd * nw1.y * silu(bfhi(z.z))); w.w = pk_bf16(b[2] * rstd * nw1.z * silu(bflo(z.w)), b[3] * rstd * nw1.w * silu(bfhi(z.w)));
        *(u32x4*)(Y + (size_t)tok * DM + 1024 + h * 256 + 32 * wid + 8 * fq) = w;
    }
}

__device__ __forceinline__ void phase_ln(const Params& p, int wid, int lane) {
    const int gw = blockIdx.x * NWAVES + wid, NGW = gridDim.x * NWAVES;
    f32x4 gg[8], bb[8];
#pragma unroll
    for (int j = 0; j < 8; ++j) { gg[j] = *((const f32x4*)p.ln_g + lane + 64 * j); bb[j] = *((const f32x4*)p.ln_b + lane + 64 * j); }
    for (int row = gw; row < SEQ; row += NGW) {
        f32x4* rp = (f32x4*)(p.out + (size_t)row * DM) + lane;
        const u32x2* xp = (const u32x2*)((const bf16_t*)(p.ws + WS_XB) + (size_t)row * DM) + lane;
        const u32x2* yp = (const u32x2*)((const bf16_t*)(p.ws + WS_KV) + (size_t)row * DM) + lane;
        f32x4 v[8]; u32x2 xw[8], yw[8]; float s = 0.f;
#pragma unroll
        for (int j = 0; j < 8; ++j) { xw[j] = __builtin_nontemporal_load(xp + 64 * j); yw[j] = __builtin_nontemporal_load(yp + 64 * j); }
#pragma unroll
        for (int j = 0; j < 8; ++j) { v[j] = (f32x4){bflo(xw[j].x), bfhi(xw[j].x), bflo(xw[j].y), bfhi(xw[j].y)} * 1.189207115002721f + (f32x4){bflo(yw[j].x), bfhi(yw[j].x), bflo(yw[j].y), bfhi(yw[j].y)}; s += (v[j].x + v[j].y) + (v[j].z + v[j].w); }
#pragma unroll
        for (int o = 1; o < 64; o <<= 1) s += __shfl_xor(s, o);
        const float mean = s * (1.f / DM); float q = 0.f;
#pragma unroll
        for (int j = 0; j < 8; ++j) { v[j] = v[j] - mean; q += (v[j].x * v[j].x + v[j].y * v[j].y) + (v[j].z * v[j].z + v[j].w * v[j].w); }
#pragma unroll
        for (int o = 1; o < 64; o <<= 1) q += __shfl_xor(q, o);
        const float rstd = 1.0f / sqrtf(q * (1.f / DM) + LN_EPS);
#pragma unroll
        for (int j = 0; j < 8; ++j) rp[64 * j] = v[j] * rstd * gg[j] + bb[j];
    }
}

struct OrderG1 {
    pg8::StaticOrder S; int deferred, c, Gg;
    __device__ void init(int G, int c_, int deferred_) { deferred = deferred_; c = c_; Gg = G / 2; S.init(SEQ, 20 * 256, G, c_); }
    __device__ bool next(int i, pg8::Unit& u) const {
        if (deferred) { if (c >= Gg) return false; const int L = c + i * Gg; if (L >= 128) return false; u.pm = L >> 1; u.pn = 19 + (L & 1); return true; }
        if (!S.next(i, u)) return false; if (u.pn == 19) u.pn = 21; return true;
    }
    __device__ __forceinline__ void a_ready(const pg8::Unit&) const {}
    __device__ __forceinline__ void done(const pg8::Unit&) const {}
};

__global__ void __launch_bounds__(NTHREADS, 2) hymba_mega(Params p) {
    extern __shared__ __attribute__((aligned(16))) unsigned char lds_raw[];
    LAS unsigned char* lds = (LAS unsigned char*)lds_raw;
    cg::grid_group grid = cg::this_grid();
    const int tid = threadIdx.x, lane = tid & 63, wid = __builtin_amdgcn_readfirstlane(tid >> 6);
    const int G = gridDim.x;
    volatile LAS unsigned* MISC = (volatile LAS unsigned*)(lds + MISC_OFF);
    if (tid < 16) MISC[tid] = 0u;
    __syncthreads();
    const XcdBarrier bar = xcd_barrier_post((unsigned*)(p.ws + WS_CTL), MISC);
    if (p.ws == nullptr) grid.sync();

    phase_prologue(p, lds, tid, wid, lane);
    xcd_barrier(bar);
    {
        pg8::Gemm g{(const bf16_t*)(p.ws + WS_XB), (const bf16_t*)(p.ws + WS_WIN), SEQ, NH, DM}; OrderG1 S; S.init(G, (int)blockIdx.x, 0);
        pg8::EpiBf16 E{(bf16_t*)(p.ws + WS_H), NH};
        pg8::gemm_phase<pg8::EpiBf16, OrderG1, true, true>(lds, g, S, E);
    }
    xcd_barrier(bar);
    {
        const int Gg = G / 2;
        if ((int)blockIdx.x < Gg) {
            pg8::Gemm g{(const bf16_t*)(p.ws + WS_XB), (const bf16_t*)(p.ws + WS_WIN), SEQ, NH, DM}; OrderG1 S; S.init(G, (int)blockIdx.x, 1);
            pg8::EpiBf16 E{(bf16_t*)(p.ws + WS_H), NH};
            pg8::gemm_phase<pg8::EpiBf16, OrderG1, true, true>(lds, g, S, E);
        } else {
            for (int u = (int)blockIdx.x - Gg; u < NCH * 4; u += G - Gg) gla_kv_unit(p, lds, u >> 2, u & 3, tid, wid, lane);
        }
    }
    xcd_barrier(bar);
    phase_scan(p, tid);
    xcd_barrier(bar);
    const bool attn_first = ((blockIdx.x >> 3) & 1) != 0;
    for (int u = attn_first ? (int)blockIdx.x : 256; u < 256; u += G) attn_unit(p, lds, u >> 1, u & 1, tid, wid, lane);
    for (int u = blockIdx.x; u < NCH * 4; u += G) gla_out_unit(p, lds, u >> 2, u & 3, tid, wid, lane);
    for (int u = attn_first ? 256 : (int)blockIdx.x; u < 256; u += G) attn_unit(p, lds, u >> 1, u & 1, tid, wid, lane);
    xcd_barrier(bar);
    {
        pg8::Gemm g{(const bf16_t*)(p.ws + WS_Y), (const bf16_t*)(p.ws + WS_WOUT), SEQ, DM, DM}; pg8::StaticOrder S; S.init(SEQ, DM, G, (int)blockIdx.x);
        pg8::EpiBf16 E{(bf16_t*)(p.ws + WS_KV), DM};
        pg8::gemm_phase<pg8::EpiBf16, pg8::StaticOrder, true, true>(lds, g, S, E);
    }
    xcd_barrier(bar);
    phase_ln(p, wid, lane);
}

extern "C" void kernel_launch(void* const* d_in, const int* in_sizes, int n_in, void* d_out, int out_size, void* d_ws, size_t ws_size, hipStream_t stream) {
    static int grid = 0;
    if (grid == 0) {
        if (n_in != 9 || out_size != SEQ * DM || ws_size < WS_END) { fprintf(stderr, "kernel_launch: unexpected shapes (n_in %d out %d ws %zu)\n", n_in, out_size, ws_size); grid = -1; return; }
        int dev = 0, cus = 0, per_cu = 0;
        hipGetDevice(&dev); hipDeviceGetAttribute(&cus, hipDeviceAttributeMultiprocessorCount, dev);
        if (hipFuncSetAttribute((const void*)hymba_mega, hipFuncAttributeMaxDynamicSharedMemorySize, LDS_BYTES) != hipSuccess) { fprintf(stderr, "kernel_launch: hipFuncSetAttribute failed\n"); grid = -1; return; }
        if (hipOccupancyMaxActiveBlocksPerMultiprocessor(&per_cu, (const void*)hymba_mega, NTHREADS, LDS_BYTES) != hipSuccess || per_cu < 1) { fprintf(stderr, "kernel_launch: occupancy query failed (%d)\n", per_cu); per_cu = 1; }
        (void)hipGetLastError();
        grid = cus * per_cu;
    }
    if (grid < 0) return;
    Params p{};
    p.x = (const float*)d_in[0]; p.w_in = (const float*)d_in[1]; p.w_gk_up = (const float*)d_in[2]; p.b_gk = (const float*)d_in[3]; p.sinks = (const float*)d_in[4];
    p.gla_norm_w = (const float*)d_in[5]; p.w_out = (const float*)d_in[6]; p.ln_g = (const float*)d_in[7]; p.ln_b = (const float*)d_in[8];
    p.out = (float*)d_out; p.ws = (unsigned char*)d_ws;
    if (hipMemsetAsync((char*)d_ws + WS_CTL, 0, CTL_BYTES, stream) != hipSuccess) { fprintf(stderr, "kernel_launch: memset failed\n"); return; }
    void* args[] = {&p};
    hipError_t e = hipLaunchCooperativeKernel((void*)hymba_mega, dim3(grid), dim3(NTHREADS), args, LDS_BYTES, stream);
    if (e != hipSuccess) fprintf(stderr, "cooperative launch failed: %s (grid %d)\n", hipGetErrorString(e), grid);
}
```
